# Optimizing an MI355X kernel written in HIP

```python
import math, functools
import jax, jax.numpy as jnp
from jax import lax
import numpy as np

D_MODEL = 1024
BATCH = 16
SEQ = 256
DEPTH = 2
DEC_BATCH = 2
DEC_SEQ = 2048
PAST_LEN = 256

GRID_W = 64
HEAD_DIM = 64
HY_CH = 256
NA_HEADS = 6
GQA_Q_HEADS = 6
GQA_KV_HEADS = 2
MIX_WIDTH = HY_CH + NA_HEADS * HEAD_DIM + GQA_Q_HEADS * HEAD_DIM
IN_WIDTH = 3 * HY_CH + 3 * NA_HEADS * HEAD_DIM + (GQA_Q_HEADS + 2 * GQA_KV_HEADS) * HEAD_DIM
D_FF = 2816
N_ADA = 9
SHORT_CONV = 3
HY_BANDS = 16
HY_EMB = 1 + 2 * HY_BANDS
HY_FILT_W = 64
HY_DECAY_TARGET = 1e-2
HY_FAST_PCT = 0.3
HY_SLOW_PCT = 1.5
NA_ROWS = 8
NA_COLS = 16
NA_QCOLS = 16
NA_KCOLS = 32
GQA_WINDOW = 128
BLK = 128
ROPE_BASE = 10000.0
EPS = 1e-6
NEG_INF = -1e30

kernel_name = "hymba_style_hyena_natten_swa_diffusion_step"


def _rmsnorm(x, g):
    xf = x.astype(jnp.float32)
    xf = xf * lax.rsqrt(jnp.mean(xf * xf, axis=-1, keepdims=True) + EPS)
    return xf.astype(x.dtype) * g


def _swiglu(h, w1, w3, w2):
    return (jax.nn.silu(h @ w1) * (h @ w3)) @ w2


def _short_conv(u, w, b):
    n = u.shape[1]
    up = jnp.pad(u, ((0, 0), (1, 1), (0, 0)))
    return up[:, 0:n] * w[0] + up[:, 1:n + 1] * w[1] + up[:, 2:n + 2] * w[2] + b


def _hyena_filter_fft(L, lp):
    f32 = jnp.float32
    idx = jnp.arange(L, dtype=f32)
    t = idx / (L - 1)
    bands = jnp.linspace(1e-4, HY_BANDS - 1, HY_BANDS, dtype=f32)
    ang = (2.0 * math.pi / L) * idx[:, None] * bands[None, :]
    feats = jnp.concatenate([t[:, None], jnp.cos(ang), -jnp.sin(ang)], axis=-1)
    freq = lp["hy_freq"].astype(f32)
    hid = jnp.sin(freq[0] * (feats @ lp["hy_filt_w1"].astype(f32) + lp["hy_filt_b1"].astype(f32)))
    hid = jnp.sin(freq[1] * (hid @ lp["hy_filt_w2"].astype(f32) + lp["hy_filt_b2"].astype(f32)))
    taps = (hid @ lp["hy_filt_w3"].astype(f32)).reshape(L, 2, HY_CH)
    max_decay = math.log(HY_DECAY_TARGET) / HY_FAST_PCT
    min_decay = math.log(HY_DECAY_TARGET) / HY_SLOW_PCT
    deltas = jnp.abs(jnp.linspace(min_decay, max_decay, HY_CH, dtype=f32))
    taps = taps * jnp.exp(-t[:, None, None] * deltas)
    two_sided = jnp.concatenate([taps[:, 0], jnp.zeros((1, HY_CH), f32), taps[:0:-1, 1]], axis=0)
    return jnp.fft.rfft(two_sided, axis=0)


def _hyena(u, lp):
    L = u.shape[1]
    uc = _short_conv(u, lp["hy_conv_w"], lp["hy_conv_b"])
    x0, x1, v = jnp.split(uc, 3, axis=-1)
    kf = _hyena_filter_fft(L, lp)
    z = (x1 * v).astype(jnp.float32)
    zf = jnp.fft.rfft(z, n=2 * L, axis=1)
    conv = jnp.fft.irfft(zf * kf[None], n=2 * L, axis=1)[:, :L]
    y = conv + z * lp["hy_skip"].astype(jnp.float32)
    return x0 * y.astype(u.dtype)


def _axial_rope(x):
    N, Dh = x.shape[1], x.shape[-1]
    pos = jnp.arange(N)
    quarter = Dh // 4
    half = Dh // 2
    inv = ROPE_BASE ** (-jnp.arange(quarter, dtype=jnp.float32) / quarter)

    def rot(xh, coord):
        ang = coord.astype(jnp.float32)[:, None] * inv[None, :]
        cos = jnp.cos(ang)[None, :, None, :].astype(x.dtype)
        sin = jnp.sin(ang)[None, :, None, :].astype(x.dtype)
        a, b = xh[..., :quarter], xh[..., quarter:]
        return jnp.concatenate([a * cos - b * sin, a * sin + b * cos], axis=-1)

    return jnp.concatenate([rot(x[..., :half], pos // GRID_W), rot(x[..., half:], pos % GRID_W)], axis=-1)


def _dense_attention(q, k, v, sink):
    B, L, Hq, Dh = q.shape
    Hkv = k.shape[2]
    G = Hq // Hkv
    nb = L // BLK
    scale = Dh ** -0.5
    qb = jnp.moveaxis(q.reshape(B, nb, BLK, Hkv, G, Dh), 1, 0)

    def block(qi):
        s = jnp.einsum("bqhgd,bkhd->bhgqk", qi, k).astype(jnp.float32) * scale
        if sink is not None:
            s_sink = jnp.broadcast_to(sink.astype(jnp.float32).reshape(1, Hkv, G, 1, 1), s.shape[:-1] + (1,))
            p = jax.nn.softmax(jnp.concatenate([s, s_sink], axis=-1), axis=-1)[..., :L]
        else:
            p = jax.nn.softmax(s, axis=-1)
        return jnp.einsum("bhgqk,bkhd->bqhgd", p.astype(v.dtype), v)

    out = lax.map(block, qb)
    return jnp.moveaxis(out, 0, 1).reshape(B, L, Hq, Dh)


def _neighbourhood_attention(q, k, v, kc, vc, rpb):
    B, N, H, Dh = q.shape
    rows = N // GRID_W
    wr = min(NA_ROWS, rows)
    nb = GRID_W // NA_QCOLS
    scale = Dh ** -0.5
    r = jnp.arange(rows)
    row_idx = jnp.clip(r - wr // 2, 0, rows - wr)[:, None] + jnp.arange(wr)[None, :]
    blk = jnp.arange(nb)
    col_idx = jnp.clip(blk * NA_QCOLS - NA_COLS // 2, 0, GRID_W - NA_KCOLS)[:, None] + jnp.arange(NA_KCOLS)[None, :]
    q_col = blk[:, None] * NA_QCOLS + jnp.arange(NA_QCOLS)[None, :]
    win_lo = jnp.clip(q_col - NA_COLS // 2, 0, GRID_W - NA_COLS)[:, :, None]
    col_ok = (col_idx[:, None, :] >= win_lo) & (col_idx[:, None, :] < win_lo + NA_COLS)
    n_loc = wr * NA_KCOLS
    mask = jnp.broadcast_to(col_ok[:, :, None, :], (nb, NA_QCOLS, wr, NA_KCOLS)).reshape(nb, NA_QCOLS, n_loc)
    dr = row_idx - r[:, None]
    dc = jnp.clip(col_idx[:, None, :] - q_col[:, :, None], 1 - NA_COLS, NA_COLS - 1)
    bias = rpb.astype(jnp.float32)[:, dr[:, None, None, :, None] + NA_ROWS - 1, dc[None, :, :, None, :] + NA_COLS - 1]
    bias = bias.reshape(H, rows, nb, NA_QCOLS, n_loc)
    gr = row_idx[:, None, :, None]
    gc = col_idx[None, :, None, :]
    kg = k.reshape(B, rows, GRID_W, H, Dh)[:, gr, gc].reshape(B, rows, nb, n_loc, H, Dh)
    vg = v.reshape(B, rows, GRID_W, H, Dh)[:, gr, gc].reshape(B, rows, nb, n_loc, H, Dh)
    qg = q.reshape(B, rows, nb, NA_QCOLS, H, Dh)
    s_loc = jnp.einsum("brnqhd,brnkhd->bhrnqk", qg, kg).astype(jnp.float32) * scale
    s_loc = jnp.where(mask[None, None, None], s_loc + bias[None], NEG_INF)
    s_ctx = jnp.einsum("brnqhd,bkhd->bhrnqk", qg, kc).astype(jnp.float32) * scale
    p = jax.nn.softmax(jnp.concatenate([s_loc, s_ctx], axis=-1), axis=-1).astype(v.dtype)
    out = (jnp.einsum("bhrnqk,brnkhd->brnqhd", p[..., :n_loc], vg)
           + jnp.einsum("bhrnqk,bkhd->brnqhd", p[..., n_loc:], vc))
    return out.reshape(B, N, H, Dh)


def _window_attention(q, k, v, kc, vc, sink):
    B, N, Hq, Dh = q.shape
    Hkv = k.shape[2]
    G = Hq // Hkv
    nb = N // BLK
    scale = Dh ** -0.5
    qb = q.reshape(B, nb, BLK, Hkv, G, Dh)
    key_idx = jnp.arange(nb)[:, None] * BLK + jnp.arange(3 * BLK)[None, :]
    pad = ((0, 0), (BLK, BLK), (0, 0), (0, 0))
    kb = jnp.pad(k, pad)[:, key_idx]
    vb = jnp.pad(v, pad)[:, key_idx]
    q_pos = jnp.arange(nb)[:, None] * BLK + jnp.arange(BLK)[None, :]
    k_pos = (key_idx - BLK)[:, None, :]
    ok = (jnp.abs(q_pos[:, :, None] - k_pos) <= GQA_WINDOW) & (k_pos >= 0) & (k_pos < N)
    s_loc = jnp.einsum("bnqhgd,bnkhd->bhgnqk", qb, kb).astype(jnp.float32) * scale
    s_loc = jnp.where(ok[None, None, None], s_loc, NEG_INF)
    s_ctx = jnp.einsum("bnqhgd,bkhd->bhgnqk", qb, kc).astype(jnp.float32) * scale
    s_sink = jnp.broadcast_to(sink.astype(jnp.float32).reshape(1, Hkv, G, 1, 1, 1), s_loc.shape[:-1] + (1,))
    p = jax.nn.softmax(jnp.concatenate([s_loc, s_ctx, s_sink], axis=-1), axis=-1).astype(v.dtype)
    n_loc = 3 * BLK
    n_ctx = kc.shape[1]
    out = (jnp.einsum("bhgnqk,bnkhd->bnqhgd", p[..., :n_loc], vb)
           + jnp.einsum("bhgnqk,bkhd->bnqhgd", p[..., n_loc:n_loc + n_ctx], vc))
    return out.reshape(B, N, Hq, Dh)


def _project(h, lp):
    u = h @ lp["w_in"]
    B, L, _ = u.shape
    s0 = 3 * HY_CH
    s1 = s0 + 3 * NA_HEADS * HEAD_DIM
    nq = GQA_Q_HEADS * HEAD_DIM
    nk = GQA_KV_HEADS * HEAD_DIM
    u_hy = u[..., :s0]
    na = u[..., s0:s1].reshape(B, L, 3, NA_HEADS, HEAD_DIM)
    na_q = _rmsnorm(na[:, :, 0], lp["na_q_g"])
    na_k = _rmsnorm(na[:, :, 1], lp["na_k_g"])
    na_v = na[:, :, 2]
    gq = u[..., s1:]
    gq_q = _rmsnorm(gq[..., :nq].reshape(B, L, GQA_Q_HEADS, HEAD_DIM), lp["gqa_q_g"])
    gq_k = _rmsnorm(gq[..., nq:nq + nk].reshape(B, L, GQA_KV_HEADS, HEAD_DIM), lp["gqa_k_g"])
    gq_v = gq[..., nq + nk:].reshape(B, L, GQA_KV_HEADS, HEAD_DIM)
    return u_hy, na_q, na_k, na_v, gq_q, gq_k, gq_v


def _merge(y_hy, y_na, y_gq, lp):
    B, L = y_hy.shape[:2]
    y = jnp.concatenate([y_hy, y_na.reshape(B, L, -1), y_gq.reshape(B, L, -1)], axis=-1)
    return y @ lp["w_out"]


def _mixer_context(h, lp):
    u_hy, na_q, na_k, na_v, gq_q, gq_k, gq_v = _project(h, lp)
    y_hy = _hyena(u_hy, lp)
    y_na = _dense_attention(na_q, na_k, na_v, None)
    y_gq = _dense_attention(gq_q, gq_k, gq_v, lp["gqa_sink"])
    return _merge(y_hy, y_na, y_gq, lp), (na_k, na_v, gq_k, gq_v)


def _mixer_latent(h, lp, na_kc, na_vc, gq_kc, gq_vc):
    u_hy, na_q, na_k, na_v, gq_q, gq_k, gq_v = _project(h, lp)
    y_hy = _hyena(u_hy, lp)
    y_na = _neighbourhood_attention(na_q, na_k, na_v, na_kc, na_vc, lp["na_rpb"])
    y_gq = _window_attention(_axial_rope(gq_q), _axial_rope(gq_k), gq_v, gq_kc, gq_vc, lp["gqa_sink"])
    return _merge(y_hy, y_na, y_gq, lp), ()


def _layer(x, cvec, lp, mixer):
    mod = jax.nn.silu(cvec) @ lp["ada_w"] + lp["ada_b"]
    sh1, sc1, g1, sh2, sc2, g2, sh3, sc3, g3 = jnp.split(mod[:, None, :], N_ADA, axis=-1)
    h = _rmsnorm(x, lp["norm_g"][0]) * (1.0 + sc1) + sh1
    x = x + 0.5 * g1 * _swiglu(h, lp["ffn_w1"][0], lp["ffn_w3"][0], lp["ffn_w2"][0])
    h = _rmsnorm(x, lp["norm_g"][1]) * (1.0 + sc2) + sh2
    y, ctx = mixer(h)
    x = x + g2 * y
    h = _rmsnorm(x, lp["norm_g"][2]) * (1.0 + sc3) + sh3
    x = x + 0.5 * g3 * _swiglu(h, lp["ffn_w1"][1], lp["ffn_w3"][1], lp["ffn_w2"][1])
    return x, ctx


def setup_inputs(seed: int = 0) -> dict:
    key = jax.random.key(seed)
    ks = jax.random.split(key, 32)
    f32 = jnp.float32

    def nrm(k, shape, s):
        return jax.random.normal(k, shape, f32) * s

    D = D_MODEL
    return {
        "x_prompt": nrm(ks[0], (BATCH, SEQ, D), 1.0),
        "x_sample": nrm(ks[1], (DEC_BATCH, DEC_SEQ, D), 1.0),
        "cache_na_k": nrm(ks[2], (DEC_BATCH, DEPTH, PAST_LEN, NA_HEADS, HEAD_DIM), 1.0),
        "cache_na_v": nrm(ks[3], (DEC_BATCH, DEPTH, PAST_LEN, NA_HEADS, HEAD_DIM), 1.0),
        "cache_gqa_k": nrm(ks[4], (DEC_BATCH, DEPTH, PAST_LEN, GQA_KV_HEADS, HEAD_DIM), 1.0),
        "cache_gqa_v": nrm(ks[5], (DEC_BATCH, DEPTH, PAST_LEN, GQA_KV_HEADS, HEAD_DIM), 1.0),
        "c": nrm(ks[6], (DEC_BATCH, D), 1.0),
        "c_ctx": nrm(ks[7], (D,), 1.0),
        "ada_w": nrm(ks[8], (DEPTH, D, N_ADA * D), 0.5 * D ** -0.5),
        "ada_b": nrm(ks[9], (DEPTH, N_ADA * D), 0.02),
        "norm_g": 1.0 + nrm(ks[10], (DEPTH, 3, D), 0.05),
        "ffn_w1": nrm(ks[11], (DEPTH, 2, D, D_FF), D ** -0.5),
        "ffn_w3": nrm(ks[12], (DEPTH, 2, D, D_FF), D ** -0.5),
        "ffn_w2": nrm(ks[13], (DEPTH, 2, D_FF, D), D_FF ** -0.5),
        "w_in": nrm(ks[14], (DEPTH, D, IN_WIDTH), D ** -0.5),
        "w_out": nrm(ks[15], (DEPTH, MIX_WIDTH, D), MIX_WIDTH ** -0.5),
        "hy_conv_w": nrm(ks[16], (DEPTH, SHORT_CONV, 3 * HY_CH), SHORT_CONV ** -0.5),
        "hy_conv_b": nrm(ks[17], (DEPTH, 3 * HY_CH), 0.02),
        "hy_filt_w1": nrm(ks[18], (DEPTH, HY_EMB, HY_FILT_W), HY_EMB ** -0.5),
        "hy_filt_b1": nrm(ks[19], (DEPTH, HY_FILT_W), 0.1),
        "hy_filt_w2": nrm(ks[20], (DEPTH, HY_FILT_W, HY_FILT_W), HY_FILT_W ** -0.5),
        "hy_filt_b2": nrm(ks[21], (DEPTH, HY_FILT_W), 0.1),
        "hy_filt_w3": nrm(ks[22], (DEPTH, HY_FILT_W, 2 * HY_CH), 0.1 * HY_FILT_W ** -0.5),
        "hy_freq": 1.0 + nrm(ks[23], (DEPTH, 2, HY_FILT_W), 0.1),
        "hy_skip": nrm(ks[24], (DEPTH, HY_CH), 0.5),
        "na_q_g": 1.0 + nrm(ks[25], (DEPTH, HEAD_DIM), 0.05),
        "na_k_g": 1.0 + nrm(ks[26], (DEPTH, HEAD_DIM), 0.05),
        "na_rpb": nrm(ks[27], (DEPTH, NA_HEADS, 2 * NA_ROWS - 1, 2 * NA_COLS - 1), 0.02),
        "gqa_q_g": 1.0 + nrm(ks[28], (DEPTH, HEAD_DIM), 0.05),
        "gqa_k_g": 1.0 + nrm(ks[29], (DEPTH, HEAD_DIM), 0.05),
        "gqa_sink": nrm(ks[30], (DEPTH, GQA_Q_HEADS), 0.5),
    }


def reference(x_prompt, x_sample, cache_na_k, cache_na_v, cache_gqa_k, cache_gqa_v, c, c_ctx,
              ada_w, ada_b, norm_g, ffn_w1, ffn_w3, ffn_w2, w_in, w_out,
              hy_conv_w, hy_conv_b, hy_filt_w1, hy_filt_b1, hy_filt_w2, hy_filt_b2, hy_filt_w3,
              hy_freq, hy_skip, na_q_g, na_k_g, na_rpb, gqa_q_g, gqa_k_g, gqa_sink):
    y_prompt = x_prompt
    y_sample = x_sample
    nk_list, nv_list, gk_list, gv_list = [], [], [], []
    for l in range(DEPTH):
        lp = {
            "ada_w": ada_w[l], "ada_b": ada_b[l], "norm_g": norm_g[l],
            "ffn_w1": ffn_w1[l], "ffn_w3": ffn_w3[l], "ffn_w2": ffn_w2[l],
            "w_in": w_in[l], "w_out": w_out[l],
            "hy_conv_w": hy_conv_w[l], "hy_conv_b": hy_conv_b[l],
            "hy_filt_w1": hy_filt_w1[l], "hy_filt_b1": hy_filt_b1[l],
            "hy_filt_w2": hy_filt_w2[l], "hy_filt_b2": hy_filt_b2[l], "hy_filt_w3": hy_filt_w3[l],
            "hy_freq": hy_freq[l], "hy_skip": hy_skip[l],
            "na_q_g": na_q_g[l], "na_k_g": na_k_g[l], "na_rpb": na_rpb[l],
            "gqa_q_g": gqa_q_g[l], "gqa_k_g": gqa_k_g[l], "gqa_sink": gqa_sink[l],
        }
        y_prompt, (nk, nv, gk, gv) = _layer(y_prompt, c_ctx[None, :], lp, functools.partial(_mixer_context, lp=lp))
        nk_list.append(nk)
        nv_list.append(nv)
        gk_list.append(gk)
        gv_list.append(gv)
        y_sample, _ = _layer(y_sample, c, lp, functools.partial(
            _mixer_latent, lp=lp, na_kc=cache_na_k[:, l], na_vc=cache_na_v[:, l],
            gq_kc=cache_gqa_k[:, l], gq_vc=cache_gqa_v[:, l]))
    new_na_k = jnp.stack(nk_list, axis=1)
    new_na_v = jnp.stack(nv_list, axis=1)
    new_gqa_k = jnp.stack(gk_list, axis=1)
    new_gqa_v = jnp.stack(gv_list, axis=1)
    return (y_prompt, y_sample, new_na_k, new_na_v, new_gqa_k, new_gqa_v)
```

```cpp
#include <hip/hip_runtime.h>
#include <hip/hip_cooperative_groups.h>
#include <cstdint>
#include <cstdio>
namespace cg = cooperative_groups;

#define DI __device__ __forceinline__
#define LAS __attribute__((address_space(3)))
typedef unsigned short bf16_t;
typedef short bf16x8 __attribute__((ext_vector_type(8)));
typedef float f32x4 __attribute__((ext_vector_type(4)));
typedef unsigned u32x4 __attribute__((ext_vector_type(4)));
typedef unsigned u32x2 __attribute__((ext_vector_type(2)));

namespace pg8 {
constexpr int BM = 256, BK = 64, HALF = 128, HTB = HALF * BK * 2, STAGE_BYTES = 8 * HTB, NXCD = 8, WGM = 8;
__host__ __device__ __forceinline__ int lds_byte(int r, int c) { const int st = (r >> 4) * 2 + (c >> 5), rr = r & 15, cc = c & 31, ob = rr * 64 + cc * 2; return st * 1024 + (ob ^ (((ob >> 9) & 1) << 5)); }
__host__ __device__ __forceinline__ void stage_rc(int b, int& R, int& C) { const int st = b / 1024, sb = b % 1024, swz = sb ^ (((sb >> 9) & 1) << 5); R = (st >> 1) * 16 + swz / 64; C = (st & 1) * 32 + (swz % 64) / 2; }
__host__ __device__ __forceinline__ int perm32(int rho) { const int n = rho >> 4, i = rho & 15; return 8 * (i >> 2) + 4 * n + (i & 3); }

struct Unit { int pm, pn; };
struct Gemm { const bf16_t* A; const bf16_t* Bt; int K, Kloop, nN, hyb; };

struct StaticOrder {
    int nM, nN, nwg, G, c;
    __device__ void init(int M, int N, int G_, int c_) { nM = M / BM; nN = N / BM; nwg = nM * nN; G = G_; c = c_; }
    __device__ bool next(int i, Unit& u) const {
        const long L = (long)i * G + c; if (L >= nwg) return false;
        int wgid = (int)L; { const int q = nwg / NXCD, r = nwg % NXCD, xcd = wgid % NXCD, off = wgid / NXCD; wgid = (xcd < r ? xcd * (q + 1) : r * (q + 1) + (xcd - r) * q) + off; }
        const int nig = WGM * nN, gid = wgid / nig, fm = gid * WGM, gsz = (nM - fm) < WGM ? (nM - fm) : WGM;
        u.pm = fm + ((wgid % nig) % gsz); u.pn = (wgid % nig) / gsz; return true;
    }
};

struct InOrder {
    int G, c;
    __device__ bool next(int i, Unit& u) const {
        const int L = i * G + c; if (L >= 384) return false;
        if (L < 256) { const int x = L & 7, w = L >> 3; u.pm = 4 * x + (w & 3); u.pn = w >> 2; } else { const int s = L - 256, x = s & 7, w = s >> 3; u.pm = 4 * x + (w & 3); u.pn = 8 + (w >> 2); }
        return true;
    }
};

__device__ __forceinline__ unsigned cvt_pk_bf16(float lo, float hi) { unsigned r; asm volatile("v_cvt_pk_bf16_f32 %0, %1, %2" : "=v"(r) : "v"(lo), "v"(hi)); return r; }
__device__ __forceinline__ void st16_wt(void* p, u32x4 w) { asm volatile("global_store_dwordx4 %0, %1, off sc1\n\ts_nop 1" :: "v"(p), "v"(w) : "memory"); }
__device__ __forceinline__ float silu_f(float a) { return a * __builtin_amdgcn_rcpf(1.0f + __expf(-a)); }

struct EpiBf16 {
    static constexpr bool PERM = true;
    bf16_t* O; int ldc;
    __device__ __forceinline__ void operator()(const f32x4 (&acc)[2][2][4][2], const Unit& u, int wr, int wc, int fr, int fq) const {
        const int row0 = u.pm * BM + wr * 64 + fr, col0 = u.pn * BM + wc * 32 + 8 * fq;
#pragma unroll
        for (int ai = 0; ai < 2; ++ai)
#pragma unroll
            for (int m = 0; m < 4; ++m) { bf16_t* rowp = O + (size_t)(row0 + ai * HALF + m * 16) * ldc + col0;
#pragma unroll
                for (int bj = 0; bj < 2; ++bj) { const f32x4 v0 = acc[ai][bj][m][0], v1 = acc[ai][bj][m][1];
                    u32x4 w; w.x = cvt_pk_bf16(v0[0], v0[1]); w.y = cvt_pk_bf16(v0[2], v0[3]); w.z = cvt_pk_bf16(v1[0], v1[1]); w.w = cvt_pk_bf16(v1[2], v1[3]);
                    st16_wt(rowp + bj * HALF, w); } }
    }
};
struct EpiInHyb {
    static constexpr bool PERM = true;
    bf16_t* O; bf16_t* P2;
    __device__ __forceinline__ void operator()(const f32x4 (&acc)[2][2][4][2], const Unit& u, int wr, int wc, int fr, int fq) const {
        const int row0 = u.pm * BM + wr * 64 + fr; bf16_t* base; int ldc, col0;
        if (u.pn < 8) { base = O; ldc = 2560; col0 = u.pn * BM + wc * 32 + 8 * fq; }
        else { const int v = u.pn - 8; base = P2 + (size_t)(v >> 1) * 8192 * 512; ldc = 512; col0 = (v & 1) * BM + wc * 32 + 8 * fq; }
#pragma unroll
        for (int ai = 0; ai < 2; ++ai)
#pragma unroll
            for (int m = 0; m < 4; ++m) { bf16_t* rowp = base + (size_t)(row0 + ai * HALF + m * 16) * ldc + col0;
#pragma unroll
                for (int bj = 0; bj < 2; ++bj) { const f32x4 v0 = acc[ai][bj][m][0], v1 = acc[ai][bj][m][1];
                    u32x4 w; w.x = cvt_pk_bf16(v0[0], v0[1]); w.y = cvt_pk_bf16(v0[2], v0[3]); w.z = cvt_pk_bf16(v1[0], v1[1]); w.w = cvt_pk_bf16(v1[2], v1[3]);
                    st16_wt(rowp + bj * HALF, w); } }
    }
};
struct EpiUp {
    static constexpr bool PERM = true;
    bf16_t* O; int ldc;
    __device__ __forceinline__ void operator()(const f32x4 (&acc)[2][2][4][2], const Unit& u, int wr, int wc, int fr, int fq) const {
        const int row0 = u.pm * BM + wr * 64 + fr, col0 = u.pn * HALF + wc * 32 + 8 * fq;
#pragma unroll
        for (int ai = 0; ai < 2; ++ai)
#pragma unroll
            for (int m = 0; m < 4; ++m) { bf16_t* rowp = O + (size_t)(row0 + ai * HALF + m * 16) * ldc + col0;
                const f32x4 a0 = acc[ai][0][m][0], a1 = acc[ai][0][m][1], b0 = acc[ai][1][m][0], b1 = acc[ai][1][m][1];
                u32x4 w;
                w.x = cvt_pk_bf16(silu_f(a0[0]) * b0[0], silu_f(a0[1]) * b0[1]); w.y = cvt_pk_bf16(silu_f(a0[2]) * b0[2], silu_f(a0[3]) * b0[3]);
                w.z = cvt_pk_bf16(silu_f(a1[0]) * b1[0], silu_f(a1[1]) * b1[1]); w.w = cvt_pk_bf16(silu_f(a1[2]) * b1[2], silu_f(a1[3]) * b1[3]);
                st16_wt(rowp, w); }
    }
};
struct EpiPart {
    static constexpr bool PERM = true;
    bf16_t* P; int ldc; int nN; size_t ks_stride;
    __device__ __forceinline__ void operator()(const f32x4 (&acc)[2][2][4][2], const Unit& u, int wr, int wc, int fr, int fq) const {
        const int ks = u.pn / nN, pnr = u.pn - ks * nN;
        const int row0 = u.pm * BM + wr * 64 + fr, col0 = pnr * BM + wc * 32 + 8 * fq;
        bf16_t* base = P + (size_t)ks * ks_stride;
#pragma unroll
        for (int ai = 0; ai < 2; ++ai)
#pragma unroll
            for (int m = 0; m < 4; ++m) { bf16_t* rowp = base + (size_t)(row0 + ai * HALF + m * 16) * ldc + col0;
#pragma unroll
                for (int bj = 0; bj < 2; ++bj) { const f32x4 v0 = acc[ai][bj][m][0], v1 = acc[ai][bj][m][1];
                    u32x4 w; w.x = cvt_pk_bf16(v0[0], v0[1]); w.y = cvt_pk_bf16(v0[2], v0[3]); w.z = cvt_pk_bf16(v1[0], v1[1]); w.w = cvt_pk_bf16(v1[2], v1[3]);
                    st16_wt(rowp + bj * HALF, w); } }
    }
};

template <class Epi, class Sched>
__device__ __forceinline__ void gemm_phase(LAS unsigned char* lds, const Gemm g, const Sched& S, const Epi& E, const int tid) {
    const int wid = __builtin_amdgcn_readfirstlane(tid >> 6), lane = tid & 63, wr = wid >> 2, wc = wid & 3, fr = lane & 15, fq = lane >> 4;
    const int K = g.K;
    unsigned voffA[2], voffB[2];
#pragma unroll
    for (int i = 0; i < 2; ++i) { int R, C; stage_rc(tid * 16 + i * 8192, R, C); const int Rb = Epi::PERM ? ((R & ~31) + perm32(R & 31)) : R;
        voffA[i] = (unsigned)(R * K + C) * 2u; voffB[i] = (unsigned)(Rb * K + C) * 2u; }
    const size_t kstep = (size_t)(BK * 2);
    const size_t hstep = (size_t)HALF * K * 2;
    const size_t tstep = 2 * hstep;
    const size_t ksbytes = (size_t)g.Kloop * 2;
    const unsigned ldsw = (unsigned)wid * 1024u;
    const int aoff = lds_byte(wr * 64 + fr, fq * 8), boff = lds_byte(wc * 32 + fr, fq * 8);
#define PG8_KS(u) (g.hyb ? ((u).pn < 8 ? 0 : (((u).pn - 8) >> 1)) : ((u).pn / g.nN))
#define PG8_CT(u) (g.hyb ? ((u).pn < 8 ? (u).pn : 8 + (((u).pn - 8) & 1)) : ((u).pn % g.nN))
#define PG8_NT(u) (g.hyb ? ((u).pn < 8 ? 2 * g.Kloop / BK : g.Kloop / BK) : g.Kloop / BK)
#define PG8_BASEA(u) ((const char*)g.A + (size_t)(u).pm * tstep + (size_t)PG8_KS(u) * ksbytes)
#define PG8_BASEB(u) ((const char*)g.Bt + (size_t)PG8_CT(u) * tstep + (size_t)PG8_KS(u) * ksbytes)
#define PG8_SA(b, h) (((b) * 2 + (h)) * HTB)
#define PG8_SB(b, h) ((4 + (b) * 2 + (h)) * HTB)
#define PG8_STAGE(bufoff, gbase, voff) do { _Pragma("unroll") for (int _i = 0; _i < 2; ++_i) \
        __builtin_amdgcn_global_load_lds((const unsigned*)((const char*)(gbase) + (voff)[_i]), (LAS unsigned*)(lds + (bufoff) + ldsw + _i * 8192), 16, 0, 0); } while (0)
#define PG8_LDA(dst, b, h) do { _Pragma("unroll") for (int m = 0; m < 4; ++m) _Pragma("unroll") for (int k = 0; k < 2; ++k) dst[m][k] = *(const LAS bf16x8*)(lds + PG8_SA(b, h) + aoff + m * 2048 + k * 1024); } while (0)
#define PG8_LDB(dst, b, h) do { _Pragma("unroll") for (int n = 0; n < 2; ++n) _Pragma("unroll") for (int k = 0; k < 2; ++k) dst[n][k] = *(const LAS bf16x8*)(lds + PG8_SB(b, h) + boff + n * 2048 + k * 1024); } while (0)
#define PG8_MMA(ai, bj, At, Bt) do { __builtin_amdgcn_s_setprio(1); _Pragma("unroll") for (int m = 0; m < 4; ++m) _Pragma("unroll") for (int n = 0; n < 2; ++n) _Pragma("unroll") for (int k = 0; k < 2; ++k) \
        acc[ai][bj][m][n] = __builtin_amdgcn_mfma_f32_16x16x32_bf16(Bt[n][k], At[m][k], acc[ai][bj][m][n], 0, 0, 0); __builtin_amdgcn_s_setprio(0); } while (0)
#define PG8_WAIT_V(n) asm volatile("s_waitcnt vmcnt(" #n ")" ::: "memory")
#define PG8_WAIT_L(n) asm volatile("s_waitcnt lgkmcnt(" #n ")" ::: "memory")
#define PG8_BAR __builtin_amdgcn_s_barrier()
#define PG8_SCHED __builtin_amdgcn_sched_barrier(0)
    Unit cur, nxt; int ui = 0;
    if (!S.next(0, cur)) return;
    f32x4 acc[2][2][4][2];
#pragma unroll
    for (int a = 0; a < 2; ++a)
#pragma unroll
        for (int b = 0; b < 2; ++b)
#pragma unroll
            for (int m = 0; m < 4; ++m)
#pragma unroll
                for (int n = 0; n < 2; ++n) acc[a][b][m][n] = (f32x4){0.f, 0.f, 0.f, 0.f};
    bf16x8 At[4][2], B0[2][2], B1[2][2];
    const char* cA = PG8_BASEA(cur); const char* cB = PG8_BASEB(cur);
    PG8_STAGE(PG8_SB(0, 0), cB, voffB); PG8_STAGE(PG8_SB(0, 1), cB + hstep, voffB); PG8_STAGE(PG8_SA(0, 0), cA, voffA); PG8_STAGE(PG8_SA(0, 1), cA + hstep, voffA);
    if (wr == 1) PG8_BAR;
    PG8_WAIT_V(2); PG8_BAR;
    PG8_STAGE(PG8_SB(1, 0), cB + kstep, voffB); PG8_STAGE(PG8_SA(1, 0), cA + kstep, voffA); PG8_STAGE(PG8_SB(1, 1), cB + hstep + kstep, voffB);
    PG8_WAIT_V(6); PG8_BAR;
    for (;;) {
        const bool has_next = S.next(ui + 1, nxt);
        const char* nA = has_next ? PG8_BASEA(nxt) : cA; const char* nB = has_next ? PG8_BASEB(nxt) : cB;
        const int nt = PG8_NT(cur);
        for (int t = 0; t < nt; t += 2) {
            const bool last = (t == nt - 2);
            const char* a1 = cA + (size_t)(t + 1) * kstep;
            const char* a2 = last ? nA : cA + (size_t)(t + 2) * kstep; const char* b2 = last ? nB : cB + (size_t)(t + 2) * kstep;
            const char* a3 = a2 + kstep; const char* b3 = b2 + kstep;
            PG8_LDB(B0, 0, 0); PG8_LDB(B1, 0, 1); PG8_SCHED; PG8_LDA(At, 0, 0); PG8_STAGE(PG8_SA(1, 1), a1 + hstep, voffA);
            PG8_WAIT_V(8); PG8_WAIT_L(0); PG8_BAR; PG8_MMA(0, 0, At, B0); PG8_MMA(0, 1, At, B1); PG8_BAR; PG8_SCHED;
            PG8_LDA(At, 0, 1); PG8_STAGE(PG8_SB(0, 0), b2, voffB); PG8_STAGE(PG8_SB(0, 1), b2 + hstep, voffB); PG8_STAGE(PG8_SA(0, 0), a2, voffA);
            PG8_WAIT_V(8); PG8_WAIT_L(0); PG8_BAR; PG8_MMA(1, 0, At, B0); PG8_MMA(1, 1, At, B1); PG8_BAR; PG8_SCHED;
            PG8_LDB(B0, 1, 0); PG8_LDB(B1, 1, 1); PG8_SCHED; PG8_LDA(At, 1, 0); PG8_STAGE(PG8_SA(0, 1), a2 + hstep, voffA);
            PG8_WAIT_V(8); PG8_WAIT_L(0); PG8_BAR; PG8_MMA(0, 0, At, B0); PG8_MMA(0, 1, At, B1); PG8_BAR; PG8_SCHED;
            PG8_LDA(At, 1, 1); PG8_STAGE(PG8_SB(1, 0), b3, voffB); PG8_STAGE(PG8_SB(1, 1), b3 + hstep, voffB); PG8_STAGE(PG8_SA(1, 0), a3, voffA);
            PG8_WAIT_V(8); PG8_WAIT_L(0); PG8_BAR; PG8_MMA(1, 0, At, B0); PG8_MMA(1, 1, At, B1); PG8_BAR; PG8_SCHED;
        }
        if (wr == 0) PG8_BAR;
        E(acc, cur, wr, wc, fr, fq);
        if (!has_next) break;
#pragma unroll
        for (int a = 0; a < 2; ++a)
#pragma unroll
            for (int b = 0; b < 2; ++b)
#pragma unroll
                for (int m = 0; m < 4; ++m)
#pragma unroll
                    for (int n = 0; n < 2; ++n) acc[a][b][m][n] = (f32x4){0.f, 0.f, 0.f, 0.f};
        cur = nxt; cA = nA; cB = nB; ++ui;
        if (wr == 1) PG8_BAR;
    }
    PG8_WAIT_V(0);
    PG8_BAR;
#undef PG8_BASEA
#undef PG8_BASEB
#undef PG8_KS
#undef PG8_CT
#undef PG8_NT
#undef PG8_SA
#undef PG8_SB
#undef PG8_STAGE
#undef PG8_LDA
#undef PG8_LDB
#undef PG8_MMA
#undef PG8_WAIT_V
#undef PG8_WAIT_L
#undef PG8_BAR
#undef PG8_SCHED
}
}

constexpr int DM = 1024, NTOK = 8192, NPR = 4096, DFF = 2816, INW = 2560;
constexpr int LDS_BYTES = 147456;
constexpr float EPSF = 1e-6f;
constexpr size_t MiB = 1u << 20;
constexpr size_t WS_WUP = 0;
constexpr size_t WS_W2T = 44 * MiB;
constexpr size_t WS_WIN = 66 * MiB;
constexpr size_t WS_WOUT = 76 * MiB;
constexpr size_t WS_ROPE = 80 * MiB + 524288;
constexpr size_t WS_KF = 81 * MiB;
constexpr size_t WS_CKN = 90 * MiB;
constexpr size_t WS_CVN = WS_CKN + 786432;
constexpr size_t WS_CKG = WS_CVN + 786432;
constexpr size_t WS_CVG = WS_CKG + 262144;
constexpr size_t WS_H = 92 * MiB;
constexpr size_t WS_U = 108 * MiB;
constexpr size_t WS_P = 152 * MiB;
constexpr size_t WS_QN = 152 * MiB, WS_KN = 158 * MiB, WS_VN = 164 * MiB, WS_QG = 170 * MiB, WS_KG = 176 * MiB, WS_VG = 178 * MiB, WS_Z = 180 * MiB, WS_X0 = 188 * MiB;
constexpr size_t WS_Y = 216 * MiB;
constexpr size_t WS_CTL = 232 * MiB, WS_MOD = WS_CTL + 16384, CTL_BYTES = 16384 + 2 * 3 * 9216 * 4;
constexpr size_t WS_KFT = 233 * MiB;
constexpr size_t WS_END = 238 * MiB;

struct Params { const float* in[31]; float* out; unsigned char* ws; };

DI unsigned f2bf(float f) { unsigned u = __float_as_uint(f); return (u + 0x7fffu + ((u >> 16) & 1u)) >> 16; }
DI unsigned pk2(float lo, float hi) { return f2bf(lo) | (f2bf(hi) << 16); }
DI unsigned pk2_fast(float lo, float hi) { return __builtin_amdgcn_perm(__float_as_uint(hi) + 0x8000u, __float_as_uint(lo) + 0x8000u, 0x07060302u); }
DI float bf2f(bf16_t v) { return __uint_as_float(((unsigned)v) << 16); }
DI float wave_sum(float v) {
#pragma unroll
    for (int o = 1; o < 64; o <<= 1) v += __shfl_xor(v, o);
    return v;
}
DI float silu_acc(float a) { return a / (1.0f + expf(-a)); }

DI void transpose_item(const float* W, int N, bf16_t* WT, int K, int k0, int n0, int dst_row0, LAS float* scr, int lane) {
    {
        const int ln4 = lane & 7, rw = lane >> 3;
        f32x4 v[8];
#pragma unroll
        for (int i = 0; i < 8; ++i) v[i] = __builtin_nontemporal_load((const f32x4*)(W + (size_t)(k0 + 8 * i + rw) * N + n0 + 4 * ln4));
#pragma unroll
        for (int i = 0; i < 8; ++i) { LAS float* d = scr + (8 * i + rw) * 33 + 4 * ln4; d[0] = v[i][0]; d[1] = v[i][1]; d[2] = v[i][2]; d[3] = v[i][3]; }
    }
    asm volatile("s_waitcnt lgkmcnt(0)" ::: "memory");
    const int c = lane & 7;
#pragma unroll
    for (int j = 0; j < 4; ++j) { const int n = (lane >> 3) + 8 * j; const LAS float* s = scr + (8 * c) * 33 + n;
        u32x4 o; o.x = pk2(s[0 * 33], s[1 * 33]); o.y = pk2(s[2 * 33], s[3 * 33]); o.z = pk2(s[4 * 33], s[5 * 33]); o.w = pk2(s[6 * 33], s[7 * 33]);
        *(u32x4*)(WT + (size_t)(dst_row0 + n) * K + k0 + 8 * c) = o; }
    asm volatile("s_waitcnt lgkmcnt(0)" ::: "memory");
}

DI void filter_item(const float* w1, const float* b1, const float* w2, const float* b2, const float* w3, const float* fr, int L, int pos, float* KF, int lane) {
    const float tpos = (float)pos / (float)(L - 1);
    float feat = 0.f;
    if (lane == 0) feat = tpos;
    else if (lane <= 32) { const int i = (lane - 1) & 15; const float band = 1e-4f + (15.0f - 1e-4f) * (float)i / 15.0f;
        const float ang = (6.283185307179586f / (float)L) * (float)pos * band; feat = (lane <= 16) ? cosf(ang) : -sinf(ang); }
    float a = b1[lane];
    for (int e = 0; e < 33; ++e) a += __shfl(feat, e) * w1[e * 64 + lane];
    const float hid1 = sinf(fr[lane] * a);
    a = b2[lane];
    for (int j = 0; j < 64; ++j) a += __shfl(hid1, j) * w2[j * 64 + lane];
    const float hid2 = sinf(fr[64 + lane] * a);
    float acc[8];
#pragma unroll
    for (int q = 0; q < 8; ++q) acc[q] = 0.f;
    for (int j = 0; j < 64; ++j) { const float hj = __shfl(hid2, j);
#pragma unroll
        for (int q = 0; q < 8; ++q) acc[q] += hj * w3[j * 512 + q * 64 + lane]; }
    const float min_decay = -3.0701134573253944f, max_decay = -15.350567286626972f;
#pragma unroll
    for (int q = 0; q < 8; ++q) {
        const int c = lane + 64 * (q & 3);
        const float delta = fabsf(min_decay + (max_decay - min_decay) * (float)c / 255.0f);
        const float val = acc[q] * expf(-tpos * delta);
        if (q < 4) KF[(size_t)(L + pos) * 256 + c] = val;
        else if (pos >= 1) KF[(size_t)(L - pos) * 256 + c] = val;
    }
}

DI void combine_norm(const float* xsP, const float* xsS, const bf16_t* Pp, const float* gate, float gfac, float* X,
                     const float* ng, const float* sc, const float* sh, bf16_t* H, int gw, int NGW, int lane) {
    for (int m0 = 4 * gw; m0 < NTOK; m0 += 4 * NGW) {
        const int mi = (m0 < NPR) ? 0 : 1 + ((m0 - NPR) >> 11);
        const float* xr = (m0 < NPR) ? xsP + (size_t)m0 * DM : xsS + (size_t)(m0 - NPR) * DM;
        f32x4 v[4][4]; u32x2 q0[4][4], q1[4][4]; f32x4 gt[4];
#pragma unroll
        for (int r = 0; r < 4; ++r)
#pragma unroll
            for (int j = 0; j < 4; ++j) { const int col = 4 * lane + 256 * j; v[r][j] = *(const f32x4*)(xr + (size_t)r * DM + col);
                if (Pp) { q0[r][j] = *(const u32x2*)(Pp + (size_t)(m0 + r) * DM + col); q1[r][j] = *(const u32x2*)(Pp + (size_t)NTOK * DM + (size_t)(m0 + r) * DM + col); } }
        if (Pp) {
#pragma unroll
            for (int j = 0; j < 4; ++j) gt[j] = *(const f32x4*)(gate + mi * 9216 + 4 * lane + 256 * j) * gfac;
        }
        f32x4 g[4], s1[4], s0[4];
        if (H) {
#pragma unroll
            for (int j = 0; j < 4; ++j) { const int col = 4 * lane + 256 * j; g[j] = *(const f32x4*)(ng + col); s1[j] = *(const f32x4*)(sc + mi * 9216 + col); s0[j] = *(const f32x4*)(sh + mi * 9216 + col); }
        }
        float ss[4];
#pragma unroll
        for (int r = 0; r < 4; ++r) { ss[r] = 0.f;
#pragma unroll
            for (int j = 0; j < 4; ++j) { const int col = 4 * lane + 256 * j;
                if (Pp) { const u32x2 a = q0[r][j], b = q1[r][j];
                    const f32x4 p0 = (f32x4){__uint_as_float(a.x << 16), __uint_as_float(a.x & 0xffff0000u), __uint_as_float(a.y << 16), __uint_as_float(a.y & 0xffff0000u)};
                    const f32x4 p1 = (f32x4){__uint_as_float(b.x << 16), __uint_as_float(b.x & 0xffff0000u), __uint_as_float(b.y << 16), __uint_as_float(b.y & 0xffff0000u)};
                    v[r][j] += gt[j] * (p0 + p1); }
                *(f32x4*)(X + (size_t)(m0 + r) * DM + col) = v[r][j];
                ss[r] += (v[r][j][0] * v[r][j][0] + v[r][j][1] * v[r][j][1]) + (v[r][j][2] * v[r][j][2] + v[r][j][3] * v[r][j][3]); } }
        if (H) {
#pragma unroll
            for (int o = 1; o < 64; o <<= 1) {
#pragma unroll
                for (int r = 0; r < 4; ++r) ss[r] += __shfl_xor(ss[r], o); }
#pragma unroll
            for (int r = 0; r < 4; ++r) { const float rr = rsqrtf(ss[r] * (1.0f / DM) + EPSF);
#pragma unroll
                for (int j = 0; j < 4; ++j) { const int col = 4 * lane + 256 * j;
                    const f32x4 h = (v[r][j] * rr) * g[j] * (1.0f + s1[j]) + s0[j];
                    u32x2 w; w.x = pk2(h[0], h[1]); w.y = pk2(h[2], h[3]);
                    *(u32x2*)(H + (size_t)(m0 + r) * DM + col) = w; } }
        }
    }
}

#define MFMA16(a, b, c) __builtin_amdgcn_mfma_f32_16x16x32_bf16((a), (b), (c), 0, 0, 0)
DI void fa_load(bf16x8 (&kf)[4], bf16x8 (&vf)[4], const bf16_t* Kt, int kst, const bf16_t* Vt, int fr, int fq) {
    const bf16_t* kr0 = Kt + (size_t)(8 * (fr >> 2) + (fr & 3)) * kst + 16 * fq;
    const bf16_t* kr1 = kr0 + (size_t)4 * kst;
    kf[0] = *(const bf16x8*)kr0; kf[1] = *(const bf16x8*)(kr0 + 8); kf[2] = *(const bf16x8*)kr1; kf[3] = *(const bf16x8*)(kr1 + 8);
#pragma unroll
    for (int db = 0; db < 4; ++db) vf[db] = *(const bf16x8*)(Vt + fq * 512 + (16 * db + fr) * 8);
}
DI void fa_scores(float* sv, const bf16x8 (&kf)[4], const bf16x8 (&qf)[2]) {
    f32x4 s0 = (f32x4){0.f, 0.f, 0.f, 0.f}, s1 = (f32x4){0.f, 0.f, 0.f, 0.f};
    s0 = MFMA16(kf[0], qf[0], s0); s1 = MFMA16(kf[2], qf[0], s1); s0 = MFMA16(kf[1], qf[1], s0); s1 = MFMA16(kf[3], qf[1], s1);
    sv[0] = s0[0]; sv[1] = s0[1]; sv[2] = s0[2]; sv[3] = s0[3]; sv[4] = s1[0]; sv[5] = s1[1]; sv[6] = s1[2]; sv[7] = s1[3];
}
template <int NQ, int NBUF>
DI void attn_item(const bf16_t* const (&Qrow)[NQ], bf16_t* const (&Yrow)[NQ], const float (&m0)[NQ], float l0,
                  const bf16_t* Kl, const bf16_t* Vl, int tok0, int tstep, int nloc,
                  const bf16_t* Kc, const bf16_t* Vc, int nctx, int kst, int mode,
                  const LAS float* rp, int drow0, int col0, int qc, int wlo, int kpos0, int qpos, int fr, int fq) {
    bf16x8 qf[NQ][2]; f32x4 o[NQ][4]; float m[NQ], l[NQ];
#pragma unroll
    for (int q = 0; q < NQ; ++q) { qf[q][0] = *(const bf16x8*)(Qrow[q] + 16 * fq); qf[q][1] = *(const bf16x8*)(Qrow[q] + 16 * fq + 8);
#pragma unroll
        for (int db = 0; db < 4; ++db) o[q][db] = (f32x4){0.f, 0.f, 0.f, 0.f};
        m[q] = m0[q]; l[q] = (fq == 0) ? l0 : 0.f; }
    const int nst = nloc + nctx;
    const int p0u = __builtin_amdgcn_readfirstlane(qpos - fr);
    bf16x8 kb[NBUF][4], vb[NBUF][4];
#define FA_LOAD_TILE(T, B) do { const bf16_t* Kp_; const bf16_t* Vp_; \
        if ((T) < nloc) { const int tok_ = tok0 + (T) * tstep; Kp_ = Kl + (size_t)tok_ * kst; Vp_ = Vl + (size_t)(tok_ >> 3) * 512; } \
        else { const int i_ = (T) - nloc; Kp_ = Kc + (size_t)(32 * i_) * kst; Vp_ = Vc + (size_t)i_ * 2048; } \
        fa_load(kb[B], vb[B], Kp_, kst, Vp_, fr, fq); } while (0)
#pragma unroll
    for (int b = 0; b < NBUF; ++b) if (b < nst) FA_LOAD_TILE(b, b);
    for (int s0 = 0; s0 < nst; s0 += NBUF) {
#pragma unroll
        for (int b = 0; b < NBUF; ++b) {
            const int st = s0 + b;
            if (st < nst) {
#pragma unroll
                for (int q = 0; q < NQ; ++q) {
                    float sv[8];
                    fa_scores(sv, kb[b], qf[q]);
                    if (st < nloc) {
                        if (mode == 1) {
                            const LAS float* rpr = rp + (drow0 + st) * 31;
#pragma unroll
                            for (int jj = 0; jj < 8; ++jj) { const int kcol = col0 + 8 * fq + jj; const bool ok = (kcol >= wlo) && (kcol < wlo + 16);
                                const int dc = min(max(kcol - qc, -15), 15);
                                sv[jj] = ok ? sv[jj] + rpr[dc + 15] : -INFINITY; }
                        } else if (mode == 2 && (kpos0 + 32 * st + 31 - p0u > 128 || kpos0 + 32 * st - (p0u + 15) < -128)) {
#pragma unroll
                            for (int jj = 0; jj < 8; ++jj) { const int dd = kpos0 + 32 * st + 8 * fq + jj - qpos; if (dd > 128 || dd < -128) sv[jj] = -INFINITY; }
                        }
                    }
                    float mx = fmaxf(fmaxf(fmaxf(sv[0], sv[1]), fmaxf(sv[2], sv[3])), fmaxf(fmaxf(sv[4], sv[5]), fmaxf(sv[6], sv[7])));
                    mx = fmaxf(mx, __shfl_xor(mx, 16)); mx = fmaxf(mx, __shfl_xor(mx, 32));
                    const float mn = fmaxf(m[q], mx), alpha = __expf(m[q] - mn);
                    float rs = 0.f;
#pragma unroll
                    for (int j = 0; j < 8; ++j) { sv[j] = __expf(sv[j] - mn); rs += sv[j]; }
                    l[q] = l[q] * alpha + rs; m[q] = mn;
                    u32x4 pw; pw.x = pk2_fast(sv[0], sv[1]); pw.y = pk2_fast(sv[2], sv[3]); pw.z = pk2_fast(sv[4], sv[5]); pw.w = pk2_fast(sv[6], sv[7]);
                    const bf16x8 pf = __builtin_bit_cast(bf16x8, pw);
#pragma unroll
                    for (int db = 0; db < 4; ++db) { o[q][db] = o[q][db] * alpha; o[q][db] = MFMA16(vb[b][db], pf, o[q][db]); }
                }
                if (st + NBUF < nst) FA_LOAD_TILE(st + NBUF, b);
            }
        }
    }
#undef FA_LOAD_TILE
#pragma unroll
    for (int q = 0; q < NQ; ++q) {
        float lq = l[q]; lq += __shfl_xor(lq, 16); lq += __shfl_xor(lq, 32);
        const float inv = 1.0f / lq;
#pragma unroll
        for (int db = 0; db < 4; ++db) { u32x2 w; w.x = pk2(o[q][db][0] * inv, o[q][db][1] * inv); w.y = pk2(o[q][db][2] * inv, o[q][db][3] * inv);
            *(u32x2*)(Yrow[q] + 16 * db + 4 * fq) = w; }
    }
}

DI void hyena_block(LAS unsigned char* lds, int tid, int c, int L, bool sample, const bf16_t* KFTx  , const bf16_t* ZT, const bf16_t* X0T, bf16_t* YT, float sk) {
    const int lane = tid & 63, wave = __builtin_amdgcn_readfirstlane(tid >> 6), fr = lane & 15, fq = lane >> 4;
    const int CP = (2 * L + 16) * 2, ZL = 3 * L;
    constexpr int ZOFF = 8 * 8224;
    __syncthreads();
    {
        const bf16_t* kft = KFTx + (size_t)c * 2 * L;
        const bool has_t = 8 * tid < 2 * L;
        u32x4 tv = (u32x4){0u, 0u, 0u, 0u};
        if (has_t) tv = *(const u32x4*)(kft + 8 * tid);
        const int tpb = L >> 3, zb = tid / tpb, zs0 = 8 * (tid - zb * tpb);
        const int zm0 = sample ? NPR + zb * 2048 : zb * 256;
        const u32x4 zv = *(const u32x4*)(ZT + (size_t)zm0 * 256 + (size_t)c * L + zs0);
#pragma unroll
        for (int k = 0; k < 2; ++k) { const int e0 = 8 * (tid + 512 * k), pb = e0 / (2 * L), off = e0 - pb * 2 * L, pos = off < L ? off : off + L;
            *(LAS u32x4*)(lds + ZOFF + 2 * (pb * ZL + pos)) = (u32x4){0u, 0u, 0u, 0u}; }
        *(LAS u32x4*)(lds + ZOFF + 2 * (zb * ZL + L + zs0)) = zv;
        if (has_t) {
            const unsigned tw[4] = {tv.x, tv.y, tv.z, tv.w};
#pragma unroll
            for (int k = 0; k < 8; ++k) { const int ee = 8 * tid + k; const unsigned short v = (unsigned short)((k & 1) ? (tw[k >> 1] >> 16) : (tw[k >> 1] & 0xffffu));
                if (ee >= 1) { const int x = 2 * L - ee;
#pragma unroll
                    for (int r = 0; r < 8; ++r) *(LAS unsigned short*)(lds + r * CP + 2 * (x + r)) = v; } }
        }
    }
    __syncthreads();
    const int nb = L >> 5;
    const int Ibase = sample ? 8 * wave : 0, bbase = sample ? 0 : 2 * wave;
    const int I = Ibase + (fr & 7), b = bbase + (fr >> 3);
    const int Dlo = max(Ibase - (nb - 1), -(nb - 1)), Dhi = min(Ibase + 7, nb - 1);
    f32x4 acc0 = (f32x4){0.f, 0.f, 0.f, 0.f}, acc1 = acc0;
    const int abase = (fr & 7) * CP + 2 * (L - 8 * (fr >> 3) + 8 * fq);
    const int bbyte = ZOFF + 2 * (b * ZL + L + 32 * I + 8 * fq);
#pragma unroll 4
    for (int D = Dlo; D <= Dhi; ++D) {
        const bf16x8 a0 = *(const LAS bf16x8*)(lds + abase - 64 * D);
        const bf16x8 a1 = *(const LAS bf16x8*)(lds + abase - 64 * D - 32);
        const bf16x8 bfr = *(const LAS bf16x8*)(lds + bbyte - 64 * D);
        acc0 = MFMA16(a0, bfr, acc0); acc1 = MFMA16(a1, bfr, acc1);
    }
    const int mb = sample ? NPR + b * 2048 : b * 256;
#pragma unroll
    for (int ib = 0; ib < 2; ++ib) {
        const int t = 32 * I + 16 * ib + 4 * fq;
        const u32x2 zz = *(const LAS u32x2*)(lds + ZOFF + 2 * (b * ZL + L + t));
        const u32x2 xx = *(const u32x2*)(X0T + (size_t)mb * 256 + (size_t)c * L + t);
        const float zf[4] = {__uint_as_float(zz.x << 16), __uint_as_float(zz.x & 0xffff0000u), __uint_as_float(zz.y << 16), __uint_as_float(zz.y & 0xffff0000u)};
        const float xf[4] = {__uint_as_float(xx.x << 16), __uint_as_float(xx.x & 0xffff0000u), __uint_as_float(xx.y << 16), __uint_as_float(xx.y & 0xffff0000u)};
        float y[4];
#pragma unroll
        for (int i = 0; i < 4; ++i) { const float a = ib ? acc1[i] : acc0[i]; y[i] = (a + zf[i] * sk) * xf[i]; }
        u32x2 w; w.x = pk2(y[0], y[1]); w.y = pk2(y[2], y[3]);
        *(u32x2*)(YT + (size_t)c * NTOK + mb + t) = w;
    }
}

#define XB_TMO      128
#define XB_XCNT(j)  (256  + 64 * (j))
#define XB_XSUB(j)  (1280 + 64 * (j))
#define XB_XGEN(j)  (2304 + 64 * (j))
#define XB_TOP      3328
#define XB_TOPGEN   3392
#define XCD_BAR_WORDS 3456
#define XB_SPIN_CAP (1u << 22)
DI unsigned xb_ld(unsigned* p)              { return __hip_atomic_load(p, __ATOMIC_RELAXED, __HIP_MEMORY_SCOPE_AGENT); }
DI unsigned xb_add(unsigned* p, unsigned v) { return __hip_atomic_fetch_add(p, v, __ATOMIC_RELAXED, __HIP_MEMORY_SCOPE_AGENT); }
DI unsigned xb_xcc_id() { return (unsigned)__builtin_amdgcn_s_getreg((3 << 11) | 20) & 0xFu; }
#define XB_SPIN(cond, bar) do { unsigned _sp = 0; while (cond) { __builtin_amdgcn_s_sleep(1); \
    if ((++_sp & 255u) == 0u) { if (xb_ld(&(bar)[XB_TMO])) break; if (_sp > XB_SPIN_CAP) { atomicAdd(&(bar)[XB_TMO], 1u); break; } } } } while (0)
struct XcdBarrier { unsigned* bar; unsigned x; volatile LAS unsigned* st; };
DI XcdBarrier xcd_barrier_post(unsigned* bar, volatile LAS unsigned* st) {
    XcdBarrier b; b.bar = bar; b.x = xb_xcc_id(); b.st = st;
    if (threadIdx.x == 0) (void)xb_add(&bar[XB_XCNT(b.x)], 1u);
    return b;
}
DI void xcd_barrier_complete(unsigned* bar, unsigned x, unsigned& nloc, unsigned& nx) {
    const unsigned G = gridDim.x * gridDim.y * gridDim.z;
    unsigned sum, cnt, mine, sp = 0u;
    for (;;) {
        sum = 0u; cnt = 0u; mine = 0u;
#pragma unroll
        for (unsigned j = 0; j < 16; ++j) { const unsigned c = xb_ld(&bar[XB_XCNT(j)]); sum += c; cnt += (c > 0u) ? 1u : 0u; mine = (j == x) ? c : mine; }
        if (sum == G) break;
        __builtin_amdgcn_s_sleep(1);
        if ((++sp & 255u) == 0u) { if (xb_ld(&bar[XB_TMO])) break; if (sp > XB_SPIN_CAP) { atomicAdd(&bar[XB_TMO], 1u); break; } }
    }
    nloc = mine > 0u ? mine : 1u; nx = cnt > 0u ? cnt : 1u;
}
DI void xcd_barrier(const XcdBarrier& b, const bool leader) {
    asm volatile("s_waitcnt vmcnt(0)" ::: "memory");
    __syncthreads();
    if (leader) {
        unsigned* bar = b.bar;
        __builtin_amdgcn_s_waitcnt(0);
        unsigned nloc = b.st[0], nx = b.st[1];
        if (nloc == 0u) { xcd_barrier_complete(bar, b.x, nloc, nx); b.st[0] = nloc; b.st[1] = nx; }
        const unsigned old = xb_add(&bar[XB_XSUB(b.x)], 1u);
        const unsigned gen = old / nloc;
        if (old + 1u == (gen + 1u) * nloc) {
            __builtin_amdgcn_fence(__ATOMIC_RELEASE, "agent");
            asm volatile("s_waitcnt vmcnt(0)" ::: "memory");
            const unsigned og = xb_add(&bar[XB_TOP], 1u);
            const unsigned tg = og / nx;
            if (og + 1u == (tg + 1u) * nx) xb_add(&bar[XB_TOPGEN], 1u);
            else XB_SPIN(xb_ld(&bar[XB_TOPGEN]) == tg, bar);
            __builtin_amdgcn_fence(__ATOMIC_ACQUIRE, "agent");
            xb_add(&bar[XB_XGEN(b.x)], 1u);
            asm volatile("s_waitcnt vmcnt(0)" ::: "memory");
        } else {
            XB_SPIN(xb_ld(&bar[XB_XGEN(b.x)]) == gen, bar);
            __builtin_amdgcn_fence(__ATOMIC_ACQUIRE, "agent");
            asm volatile("s_waitcnt vmcnt(0)" ::: "memory");
        }
    }
    __syncthreads();
}
constexpr int MISC_OFF = 131072 + 320;

typedef const __attribute__((address_space(4))) Params* KP;
#define PH_BEGIN \
    KP kp = (KP)__builtin_amdgcn_kernarg_segment_ptr(); asm volatile("" : "+s"(kp)); \
    unsigned lz_ = 0u; asm volatile("" : "+v"(lz_));     \
    int tid = wv * 64 + (int)__builtin_amdgcn_mbcnt_hi(~0u, __builtin_amdgcn_mbcnt_lo(~0u, lz_)); \
    const int lane = tid & 63, wave = __builtin_amdgcn_readfirstlane(tid >> 6), bid = blockIdx.x, NB = gridDim.x; \
    const int gw = bid * 8 + wave, NGW = NB * 8; \
    unsigned char* ws = kp->ws; (void)lane; (void)gw; (void)NGW; (void)ws;

DI void convert_item(KP kp, unsigned char* ws, int it, LAS float* scr, int lane) {
    const int l = it / 10240; const int r = it % 10240;
    if (r < 8448) { const int j = r / 1408, r2 = r % 1408;
        if (j < 4) { const int f = j & 1, w3 = j >> 1;
            const float* W = (w3 ? kp->in[12] : kp->in[11]) + (size_t)(l * 2 + f) * 1024 * 2816;
            const int kb = r2 / 88, nb = r2 % 88, n0 = 32 * nb;
            transpose_item(W, 2816, (bf16_t*)(ws + WS_WUP) + (size_t)(l * 2 + f) * 5632 * 1024, 1024, 64 * kb, n0, 256 * (n0 >> 7) + 128 * w3 + (n0 & 127), scr, lane);
        } else { const int f = j - 4; const float* W = kp->in[13] + (size_t)(l * 2 + f) * 2816 * 1024;
            const int kb = r2 / 32, nb = r2 % 32;
            transpose_item(W, 1024, (bf16_t*)(ws + WS_W2T) + (size_t)(l * 2 + f) * 1024 * 2816, 2816, 64 * kb, 32 * nb, 32 * nb, scr, lane); }
    } else if (r < 9728) { const int r2 = r - 8448, kb = r2 / 80, nb = r2 % 80;
        transpose_item(kp->in[14] + (size_t)l * 1024 * 2560, 2560, (bf16_t*)(ws + WS_WIN) + (size_t)l * 2560 * 1024, 1024, 64 * kb, 32 * nb, 32 * nb, scr, lane);
    } else { const int r2 = r - 9728, kb = r2 / 32, nb = r2 % 32;
        transpose_item(kp->in[15] + (size_t)l * 1024 * 1024, 1024, (bf16_t*)(ws + WS_WOUT) + (size_t)l * 1024 * 1024, 1024, 64 * kb, 32 * nb, 32 * nb, scr, lane); }
}
DI void convert_segs(KP kp, unsigned char* ws, LAS unsigned char* lds, int wave, int lane, int widx, int nw, int s0, int c0, int s1, int c1, int s2, int c2) {
    LAS float* scr = (LAS float*)(lds + wave * 16384);
    const int total = c0 + c1 + c2;
    for (int q = widx; q < total; q += nw) { const int it = q < c0 ? s0 + q : (q < c0 + c1 ? s1 + (q - c0) : s2 + (q - c0 - c1)); convert_item(kp, ws, it, scr, lane); }
}

DI void phase0(LAS unsigned char* lds, int wv) {
    PH_BEGIN
    const int gtid = bid * 512 + tid, NGT = NB * 512;
    float* MOD = (float*)(ws + WS_MOD);
    {
        const float* cctx = kp->in[7]; const float* cs = kp->in[6]; const float* ab = kp->in[9];
        LAS float* sl = (LAS float*)(lds + 131072 + 1024);
        for (int i = tid; i < 3072; i += 512) sl[i] = silu_acc(i < 1024 ? cctx[i] : cs[i - 1024]);
        __syncthreads();
        LAS float* red = (LAS float*)lds;
        for (int it = gw; it < 2304; it += NGW) {
            const int itb = it - wave, l = itb / 1152, r = itb % 1152, cgp = r >> 5, kc = (r & 31) + wave, col = 256 * cgp + 4 * lane;
            const float* aw = kp->in[8] + (size_t)l * 1024 * 9216 + (size_t)(32 * kc) * 9216 + col;
            f32x4 a0 = (f32x4){0.f, 0.f, 0.f, 0.f}, a1 = a0, a2 = a0;
#pragma unroll
            for (int k = 0; k < 32; ++k) {
                const f32x4 wv = __builtin_nontemporal_load((const f32x4*)(aw + (size_t)k * 9216));
                const float s0 = sl[32 * kc + k], s1 = sl[1024 + 32 * kc + k], s2 = sl[2048 + 32 * kc + k];
                a0 += s0 * wv; a1 += s1 * wv; a2 += s2 * wv;
            }
            *(LAS f32x4*)(red + (wave * 3 + 0) * 256 + 4 * lane) = a0; *(LAS f32x4*)(red + (wave * 3 + 1) * 256 + 4 * lane) = a1; *(LAS f32x4*)(red + (wave * 3 + 2) * 256 + 4 * lane) = a2;
            __syncthreads();
            for (int o = tid; o < 768; o += 512) { const int mi = o >> 8, cc = o & 255;
                float sacc = ((r & 31) == 0) ? ab[l * 9216 + 256 * cgp + cc] : 0.f;
#pragma unroll
                for (int w = 0; w < 8; ++w) sacc += red[(w * 3 + mi) * 256 + cc];
                unsafeAtomicAdd(MOD + (size_t)(l * 3 + mi) * 9216 + 256 * cgp + cc, sacc); }
            __syncthreads();
        }
    }
    LAS float* scr = (LAS float*)(lds + wave * 16384);
    if (NB == 256) convert_segs(kp, ws, lds, wave, lane, gw, NGW, 0, 1408, 2816, 1408, 0, 0);
    else convert_segs(kp, ws, lds, wave, lane, gw, NGW, 0, 20480, 0, 0, 0, 0);
    for (int it = gw; it < 4608; it += NGW) {
        const int l = it / 2304, r = it % 2304;
        float* KFl = (float*)(ws + WS_KF) + (size_t)l * 1179648;
        const float* w1 = kp->in[18] + (size_t)l * 33 * 64; const float* b1 = kp->in[19] + l * 64;
        const float* w2 = kp->in[20] + (size_t)l * 64 * 64; const float* b2 = kp->in[21] + l * 64;
        const float* w3 = kp->in[22] + (size_t)l * 64 * 512; const float* frq = kp->in[23] + l * 128;
        if (r < 256) filter_item(w1, b1, w2, b2, w3, frq, 256, r, KFl, lane);
        else filter_item(w1, b1, w2, b2, w3, frq, 2048, r - 256, KFl + 131072, lane);
    }
    {
        bf16_t* CKN = (bf16_t*)(ws + WS_CKN); bf16_t* CVN = (bf16_t*)(ws + WS_CVN); bf16_t* CKG = (bf16_t*)(ws + WS_CKG); bf16_t* CVG = (bf16_t*)(ws + WS_CVG);
        const float* cnk = kp->in[2]; const float* cnv = kp->in[3]; const float* cgk = kp->in[4]; const float* cgv = kp->in[5];
        for (int i = gtid; i < 393216; i += NGT) {
            CKN[i] = (bf16_t)f2bf(cnk[i]);
            const int kk = i & 7, d = (i >> 3) & 63, kg = (i >> 9) & 31, key = 8 * kg + kk, h = (i >> 14) % 6, bl = i / 98304;
            CVN[i] = (bf16_t)f2bf(cnv[((size_t)(bl * 256 + key) * 6 + h) * 64 + d]);
        }
        float* ROPE = (float*)(ws + WS_ROPE);
        for (int i = gtid; i < 65536; i += NGT) { const int t = i >> 5, k = i & 31;
            const float ang = (float)(k < 16 ? (t >> 6) : (t & 63)) * expf(-(float)(k & 15) * (9.210340371976184f / 16.0f));
            ROPE[2 * i] = cosf(ang); ROPE[2 * i + 1] = sinf(ang); }
        for (int i = gtid; i < 131072; i += NGT) {
            CKG[i] = (bf16_t)f2bf(cgk[i]);
            const int kk = i & 7, d = (i >> 3) & 63, kg = (i >> 9) & 31, key = 8 * kg + kk, h = (i >> 14) & 1, bl = i >> 15;
            CVG[i] = (bf16_t)f2bf(cgv[((size_t)(bl * 256 + key) * 2 + h) * 64 + d]);
        }
    }
}

DI void ph_combine(LAS unsigned char* lds, int l, int s, bool fin, int wv) {
    PH_BEGIN
    float* MOD = (float*)(ws + WS_MOD); float* X = kp->out; const bf16_t* Pb = (const bf16_t*)(ws + WS_P); bf16_t* Hb = (bf16_t*)(ws + WS_H);
    if (fin) { combine_norm(X, X + (size_t)NPR * DM, Pb, MOD + (size_t)3 * 9216 + 8 * 1024, 0.5f, X, nullptr, nullptr, nullptr, nullptr, gw, NGW, lane); return; }
    const float* MODl = MOD + (size_t)l * 3 * 9216;
    const bool first = (l == 0 && s == 0);
    const float* gate = first ? nullptr : (s == 0 ? MOD + (size_t)(l - 1) * 3 * 9216 + 8 * 1024 : MODl + (s == 1 ? 2 : 5) * 1024);
    const float gfac = (s == 2) ? 1.0f : 0.5f;
    combine_norm(first ? kp->in[0] : X, first ? kp->in[1] : X + (size_t)NPR * DM, first ? nullptr : Pb, gate, gfac, X,
                 kp->in[10] + (size_t)(l * 3 + s) * 1024, MODl + (3 * s + 1) * 1024, MODl + (3 * s) * 1024, Hb, gw, NGW, lane);
    if (first) {
        LAS float* scr = (LAS float*)(lds + wave * 16384);
        for (int it = gw; it < 1152; it += NGW) { const int ll = it / 576, r = it % 576;
            const float* KFl = (const float*)(ws + WS_KF) + (size_t)ll * 1179648; bf16_t* KFTl = (bf16_t*)(ws + WS_KFT) + (size_t)ll * 1179648;
            if (r < 64) transpose_item(KFl, 256, KFTl, 512, 64 * (r >> 3), 32 * (r & 7), 32 * (r & 7), scr, lane);
            else { const int r2 = r - 64; transpose_item(KFl + 131072, 256, KFTl + 131072, 4096, 64 * (r2 >> 3), 32 * (r2 & 7), 32 * (r2 & 7), scr, lane); } }
    }
}

DI void ph_up(LAS unsigned char* lds, int l, int f, int wv) {
    PH_BEGIN
    pg8::Gemm g{(const bf16_t*)(ws + WS_H), (const bf16_t*)(ws + WS_WUP) + (size_t)(l * 2 + f) * 5632 * 1024, 1024, 1024, 22, 0};
    pg8::StaticOrder S; S.init(NTOK, 5632, NB, bid);
    pg8::EpiUp E{(bf16_t*)(ws + WS_U), DFF};
    pg8::gemm_phase<pg8::EpiUp, pg8::StaticOrder>(lds, g, S, E, tid);
    if (NB == 256 && bid >= 192) {
        const int w = (bid - 192) * 8 + wave, L = 10240 * l;
        if (f == 0) convert_segs(kp, ws, lds, wave, lane, w, 512, L + 5632, 1408, L + 8448, 1280, 10240 + 2816 + 256, l == 0 ? 1152 : 0);
        else if (l == 0) convert_segs(kp, ws, lds, wave, lane, w, 512, 7040, 1408, 10240, 1408, 10240 + 2816, 256);
        else convert_segs(kp, ws, lds, wave, lane, w, 512, L + 7040, 1408, 0, 0, 0, 0);
    }
}
DI void ph_part(LAS unsigned char* lds, int l, int f, bool is_out, int wv) {
    PH_BEGIN
    pg8::Gemm g;
    if (is_out) g = pg8::Gemm{(const bf16_t*)(ws + WS_Y), (const bf16_t*)(ws + WS_WOUT) + (size_t)l * 1024 * 1024, 1024, 512, 4, 0};
    else g = pg8::Gemm{(const bf16_t*)(ws + WS_U), (const bf16_t*)(ws + WS_W2T) + (size_t)(l * 2 + f) * 1024 * 2816, 2816, 1408, 4, 0};
    pg8::StaticOrder S; S.init(NTOK, 2048, NB, bid);
    pg8::EpiPart E{(bf16_t*)(ws + WS_P), DM, 4, (size_t)NTOK * DM};
    pg8::gemm_phase<pg8::EpiPart, pg8::StaticOrder>(lds, g, S, E, tid);
}
DI void ph_in(LAS unsigned char* lds, int l, int wv) {
    PH_BEGIN
    pg8::Gemm g{(const bf16_t*)(ws + WS_H), (const bf16_t*)(ws + WS_WIN) + (size_t)l * 2560 * 1024, 1024, 512, 10, 1};
    pg8::InOrder S{NB, bid};
    pg8::EpiInHyb E{(bf16_t*)(ws + WS_U), (bf16_t*)(ws + WS_Y)};
    pg8::gemm_phase<pg8::EpiInHyb, pg8::InOrder>(lds, g, S, E, tid);
    if (NB == 256 && bid >= 128) { const int L = 10240 * l;
        convert_segs(kp, ws, lds, wave, lane, (bid - 128) * 8 + wave, 1024, L + 9728, 512, L + 1408, 1408, L + 4224, 1408); }
}

DI void unpack8(float (&f)[8], const u32x4 w) {
    f[0] = __uint_as_float(w.x << 16); f[1] = __uint_as_float(w.x & 0xffff0000u); f[2] = __uint_as_float(w.y << 16); f[3] = __uint_as_float(w.y & 0xffff0000u);
    f[4] = __uint_as_float(w.z << 16); f[5] = __uint_as_float(w.z & 0xffff0000u); f[6] = __uint_as_float(w.w << 16); f[7] = __uint_as_float(w.w & 0xffff0000u);
}
DI u32x4 pack8(const float (&f)[8]) { u32x4 w; w.x = pk2(f[0], f[1]); w.y = pk2(f[2], f[3]); w.z = pk2(f[4], f[5]); w.w = pk2(f[6], f[7]); return w; }
DI void ph_post(int l, int wv) {
    PH_BEGIN
    const bf16_t* Ub = (const bf16_t*)(ws + WS_U); const bf16_t* P2 = (const bf16_t*)(ws + WS_Y);
    bf16_t* QN = (bf16_t*)(ws + WS_QN); bf16_t* KN = (bf16_t*)(ws + WS_KN); bf16_t* VN = (bf16_t*)(ws + WS_VN);
    bf16_t* QG = (bf16_t*)(ws + WS_QG); bf16_t* KG = (bf16_t*)(ws + WS_KG); bf16_t* VG = (bf16_t*)(ws + WS_VG);
    bf16_t* ZT = (bf16_t*)(ws + WS_Z); bf16_t* X0T = (bf16_t*)(ws + WS_X0);
    const float* ROPE = (const float*)(ws + WS_ROPE);
    float* out_nak = kp->out + 8388608; float* out_nav = out_nak + 3145728; float* out_gk = out_nav + 3145728; float* out_gv = out_gk + 1048576;
    const float* naqg = kp->in[25] + l * 64; const float* nakg = kp->in[26] + l * 64; const float* gqg = kp->in[28] + l * 64; const float* gkg = kp->in[29] + l * 64;
    const float* cw = kp->in[16] + (size_t)l * 3 * 768; const float* cb = kp->in[17] + (size_t)l * 768;
    {
        const int s8 = lane & 7, hl = lane >> 3;
        auto proc = [&](const int m, const int hf, const u32x4 (&raw)[2], const u32x4 (&raw2)[2]) {
            const bool isS = m >= NPR; const int t = isS ? ((m - NPR) & 2047) : (m & 255);
            const size_t ob = isS ? 0 : ((size_t)((m >> 8) * 2 + l) * 256 + t);
#pragma unroll
            for (int k = 0; k < 2; ++k) {
                const int hd = hf * 16 + 8 * k + hl;
                float x[8]; unpack8(x, raw[k]);
                if (hd >= 20) { float x2[8]; unpack8(x2, raw2[k]);
#pragma unroll
                    for (int e = 0; e < 8; ++e) x[e] += x2[e]; }
                float ss = 0.f;
#pragma unroll
                for (int e = 0; e < 8; ++e) ss += x[e] * x[e];
                ss += __shfl_xor(ss, 1); ss += __shfl_xor(ss, 2); ss += __shfl_xor(ss, 4);
                const float r = rsqrtf(ss * (1.0f / 64.0f) + EPSF);
                const bool isq = hd < 6 || (hd >= 18 && hd < 24), isk = (hd >= 6 && hd < 12) || (hd >= 24 && hd < 26), isv = (hd >= 12 && hd < 18) || (hd >= 26 && hd < 28);
                const bool gq = hd >= 18;
                if (isq || isk) {
                    const float* g = (hd < 6 ? naqg : hd < 12 ? nakg : hd < 24 ? gqg : gkg) + 8 * s8;
                    const f32x4 g0 = *(const f32x4*)g, g1 = *(const f32x4*)(g + 4);
                    float y[8];
#pragma unroll
                    for (int e = 0; e < 8; ++e) y[e] = x[e] * r * (e < 4 ? g0[e] : g1[e - 4]);
                    if (isk && !isS) { float* od = (hd < 12) ? out_nak + ob * 384 + (hd - 6) * 64 + 8 * s8 : out_gk + ob * 128 + (hd - 24) * 64 + 8 * s8;
                        *(f32x4*)od = (f32x4){y[0], y[1], y[2], y[3]}; *(f32x4*)(od + 4) = (f32x4){y[4], y[5], y[6], y[7]}; }
                    if (gq && isS) {
                        const float* rt = ROPE + ((size_t)t * 32 + (s8 < 4 ? 0 : 16) + 8 * (s8 & 1)) * 2;
                        const f32x4 c0 = *(const f32x4*)rt, c1 = *(const f32x4*)(rt + 4), c2 = *(const f32x4*)(rt + 8), c3 = *(const f32x4*)(rt + 12);
                        const float cs[16] = {c0[0], c0[1], c0[2], c0[3], c1[0], c1[1], c1[2], c1[3], c2[0], c2[1], c2[2], c2[3], c3[0], c3[1], c3[2], c3[3]};
#pragma unroll
                        for (int e = 0; e < 8; ++e) { const float pr = __shfl_xor(y[e], 2); const float co = cs[2 * e], si = cs[2 * e + 1];
                            y[e] = (s8 & 2) ? (pr * si + y[e] * co) : (y[e] * co - pr * si); }
                    }
                    if (isq) {
#pragma unroll
                        for (int e = 0; e < 8; ++e) y[e] *= 0.125f;
                    }
                    bf16_t* dst = hd < 6 ? QN + (size_t)m * 384 + hd * 64 : hd < 12 ? KN + (size_t)m * 384 + (hd - 6) * 64 : hd < 24 ? QG + (size_t)m * 384 + (hd - 18) * 64 : KG + (size_t)m * 128 + (hd - 24) * 64;
                    *(u32x4*)(dst + 8 * s8) = pack8(y);
                } else if (isv && !isS) {
                    float* od = (hd < 18) ? out_nav + ob * 384 + (hd - 12) * 64 + 8 * s8 : out_gv + ob * 128 + (hd - 26) * 64 + 8 * s8;
                    *(f32x4*)od = (f32x4){x[0], x[1], x[2], x[3]}; *(f32x4*)(od + 4) = (f32x4){x[4], x[5], x[6], x[7]};
                }
            }
        };
        auto ldraw = [&](const int m, const int hf, u32x4 (&raw)[2], u32x4 (&raw2)[2]) {
#pragma unroll
            for (int k = 0; k < 2; ++k) { const int hd = hf * 16 + 8 * k + hl; raw2[k] = (u32x4){0u, 0u, 0u, 0u};
                if (hd < 20) raw[k] = *(const u32x4*)(Ub + (size_t)m * INW + 768 + hd * 64 + 8 * s8);
                else if (hd < 28) { const bf16_t* p = P2 + (size_t)m * 512 + (hd - 20) * 64 + 8 * s8; raw[k] = *(const u32x4*)p; raw2[k] = *(const u32x4*)(p + (size_t)8192 * 512); }
                else raw[k] = (u32x4){0u, 0u, 0u, 0u}; }
        };
        for (int it = gw; it < 2 * NTOK; it += 2 * NGW) {
            const int it2 = it + NGW; const bool has2 = it2 < 2 * NTOK;
            u32x4 rawA[2], rawB[2], rawA2[2], rawB2[2];
            ldraw(it >> 1, it & 1, rawA, rawA2);
            if (has2) ldraw(it2 >> 1, it2 & 1, rawB, rawB2);
            proc(it >> 1, it & 1, rawA, rawA2);
            if (has2) proc(it2 >> 1, it2 & 1, rawB, rawB2);
        }
    }
    for (int it = gw; it < 4096; it += NGW) {
        const int tg = it >> 2, cgp = it & 3, mb = tg * 8, c = 64 * cgp + lane;
        const bool isS = mb >= NPR; const int T = isS ? 2048 : 256;
        const int m0 = isS ? NPR + ((mb - NPR) >> 11) * 2048 : (mb >> 8) * 256, t0 = mb - m0;
        float uc[3][8];
#pragma unroll
        for (int part = 0; part < 3; ++part) { const int cc = c + 256 * part;
            float u[10];
#pragma unroll
            for (int i = 0; i < 10; ++i) { const int tt = t0 - 1 + i; u[i] = (tt >= 0 && tt < T) ? bf2f(Ub[(size_t)(mb - 1 + i) * INW + cc]) : 0.f; }
            const float w0 = cw[cc], w1 = cw[768 + cc], w2 = cw[1536 + cc], bb = cb[cc];
#pragma unroll
            for (int j = 0; j < 8; ++j) uc[part][j] = u[j] * w0 + u[j + 1] * w1 + u[j + 2] * w2 + bb; }
        float z[8];
#pragma unroll
        for (int j = 0; j < 8; ++j) z[j] = uc[1][j] * uc[2][j];
        const size_t off = (size_t)m0 * 256 + (size_t)c * T + t0;
        *(u32x4*)(ZT + off) = pack8(z); *(u32x4*)(X0T + off) = pack8(uc[0]);
    }
    for (int it = gw; it < 8192; it += NGW) {
        const int g8 = it >> 3, hh = it & 7, mb = g8 * 8;
        const bool isS = mb >= NPR; const int T = isS ? 2048 : 256;
        const int m0 = isS ? NPR + ((mb - NPR) >> 11) * 2048 : (mb >> 8) * 256, t0 = mb - m0;
        float v[8];
        if (hh < 6) {
#pragma unroll
            for (int i = 0; i < 8; ++i) v[i] = bf2f(Ub[(size_t)(mb + i) * INW + 1536 + hh * 64 + lane]);
        } else {
#pragma unroll
            for (int i = 0; i < 8; ++i) { const size_t o = (size_t)(mb + i) * 512 + 384 + (hh - 6) * 64 + lane; v[i] = bf2f(P2[o]) + bf2f(P2[o + (size_t)8192 * 512]); }
        }
        bf16_t* dst = hh < 6 ? VN + (size_t)m0 * 384 + (size_t)hh * 64 * T + (size_t)(t0 >> 3) * 512 + lane * 8
                             : VG + (size_t)m0 * 128 + (size_t)(hh - 6) * 64 * T + (size_t)(t0 >> 3) * 512 + lane * 8;
        *(u32x4*)dst = pack8(v);
    }
}

DI void mix_hyena(LAS unsigned char* lds, int l, int wv) {
    PH_BEGIN
    const bf16_t* ZT = (const bf16_t*)(ws + WS_Z); const bf16_t* X0T = (const bf16_t*)(ws + WS_X0); bf16_t* YT = (bf16_t*)(ws + WS_Z + 4 * MiB);
    const bf16_t* KFTl = (const bf16_t*)(ws + WS_KFT) + (size_t)l * 1179648;
    const float* skip = kp->in[24] + l * 256;
    {
        const float* rpb = kp->in[27] + (size_t)l * 6 * 15 * 31; LAS float* rl = (LAS float*)(lds + 98304);
        for (int i = tid; i < 2790; i += 512) rl[i] = rpb[i];
        __syncthreads();
    }
    for (int c = bid; c < 256; c += NB) {
        const float sk = skip[c];
        hyena_block(lds, tid, c, 2048, true, KFTl + 131072, ZT, X0T, YT, sk);
        hyena_block(lds, tid, c, 256, false, KFTl, ZT, X0T, YT, sk);
    }
}
DI void mix_gqa(int l, int wv) {
    PH_BEGIN
    const int vgw = ((NB & 7) == 0 ? (bid & 7) * (NB >> 3) + (bid >> 3) : bid) * 8 + wave;
    const int fr = lane & 15, fq = lane >> 4;
    const bf16_t* QG = (const bf16_t*)(ws + WS_QG); const bf16_t* KG = (const bf16_t*)(ws + WS_KG); const bf16_t* VG = (const bf16_t*)(ws + WS_VG);
    const bf16_t* CKG = (const bf16_t*)(ws + WS_CKG); const bf16_t* CVG = (const bf16_t*)(ws + WS_CVG); bf16_t* Yb = (bf16_t*)(ws + WS_Y);
    const float* sink = kp->in[30] + l * 6;
    for (int rnd = 0; rnd * NGW < 3584; ++rnd) {
        const int j = rnd * NGW + ((rnd & 1) ? NGW - 1 - vgw : vgw);
        if (j >= 1024) continue;
        const bool lat = j < 512;
        int b, hk, qt, mbase, T, tok0, nloc, nctx, kpos0; const bf16_t* Kc; const bf16_t* Vc;
        if (lat) { b = j >> 8; hk = (j >> 7) & 1; qt = j & 127; mbase = NPR + b * 2048; T = 2048;
            const int p0 = 16 * qt, kt_lo = max((p0 - 128) >> 5, 0), kt_hi = min((p0 + 143) >> 5, 63); tok0 = 32 * kt_lo; nloc = kt_hi - kt_lo + 1; nctx = 8; kpos0 = tok0;
            const int bl = b * 2 + l; Kc = CKG + (size_t)(bl * 256) * 128 + hk * 64; Vc = CVG + (size_t)(bl * 2 + hk) * 64 * 256; }
        else { const int idx = j - 512; b = idx >> 5; hk = (idx >> 4) & 1; qt = idx & 15; mbase = b * 256; T = 256; tok0 = 0; nloc = 8; nctx = 0; kpos0 = 0; Kc = nullptr; Vc = nullptr; }
        const int mq = mbase + 16 * qt + fr;
        const bf16_t* Qr[3]; bf16_t* Yr[3]; float ms[3];
#pragma unroll
        for (int q = 0; q < 3; ++q) { const int h = 3 * hk + q; Qr[q] = QG + (size_t)mq * 384 + h * 64; Yr[q] = Yb + (size_t)mq * DM + 640 + h * 64; ms[q] = sink[h]; }
        attn_item<3, 3>(Qr, Yr, ms, 1.f, KG + (size_t)mbase * 128 + hk * 64, VG + (size_t)mbase * 128 + (size_t)hk * 64 * T, tok0, 32, nloc,
                        Kc, Vc, nctx, 128, lat ? 2 : 0, nullptr, 0, 0, 0, 0, kpos0, 16 * qt + fr, fr, fq);
    }
}
DI void mix_nac(int l, int wv) {
    PH_BEGIN
    const int vgw = ((NB & 7) == 0 ? (bid & 7) * (NB >> 3) + (bid >> 3) : bid) * 8 + wave;
    const int fr = lane & 15, fq = lane >> 4;
    const bf16_t* QN = (const bf16_t*)(ws + WS_QN); const bf16_t* KN = (const bf16_t*)(ws + WS_KN); const bf16_t* VN = (const bf16_t*)(ws + WS_VN); bf16_t* Yb = (bf16_t*)(ws + WS_Y);
    for (int rnd = 0; rnd * NGW < 3584; ++rnd) {
        const int j = rnd * NGW + ((rnd & 1) ? NGW - 1 - vgw : vgw);
        if (j < 1024 || j >= 1792) continue;
        const int idx = j - 1024, b = idx / 48, rem = idx % 48, h = rem >> 3, qp = rem & 7, m0 = b * 256;
        const bf16_t* Qr[2]; bf16_t* Yr[2]; const float ms[2] = {-1e30f, -1e30f};
#pragma unroll
        for (int q = 0; q < 2; ++q) { const int mq = m0 + 16 * (2 * qp + q) + fr; Qr[q] = QN + (size_t)mq * 384 + h * 64; Yr[q] = Yb + (size_t)mq * DM + 256 + h * 64; }
        attn_item<2, 4>(Qr, Yr, ms, 0.f, KN + (size_t)m0 * 384 + h * 64, VN + (size_t)m0 * 384 + (size_t)h * 64 * 256, 0, 32, 8,
                        nullptr, nullptr, 0, 384, 0, nullptr, 0, 0, 0, 0, 0, 0, fr, fq);
    }
}
DI void mix_nas(LAS unsigned char* lds, int l, int wv) {
    PH_BEGIN
    const int vgw = ((NB & 7) == 0 ? (bid & 7) * (NB >> 3) + (bid >> 3) : bid) * 8 + wave;
    const int fr = lane & 15, fq = lane >> 4;
    const bf16_t* QN = (const bf16_t*)(ws + WS_QN); const bf16_t* KN = (const bf16_t*)(ws + WS_KN); const bf16_t* VN = (const bf16_t*)(ws + WS_VN);
    const bf16_t* CKN = (const bf16_t*)(ws + WS_CKN); const bf16_t* CVN = (const bf16_t*)(ws + WS_CVN); bf16_t* Yb = (bf16_t*)(ws + WS_Y);
    const LAS float* rpb = (const LAS float*)(lds + 98304);
    for (int rnd = 0; rnd * NGW < 3584; ++rnd) {
        const int j = rnd * NGW + ((rnd & 1) ? NGW - 1 - vgw : vgw);
        if (j < 2048 || j >= 3584) continue;
        const int idx = j - 2048, b = idx / 768, rem = idx % 768, h = rem >> 7, qt = rem & 127, r = qt >> 2, nb = qt & 3;
        const int ms0 = NPR + b * 2048, mq = ms0 + 16 * qt + fr, bl = b * 2 + l;
        const int row0 = min(max(r - 4, 0), 24), col0 = min(max(16 * nb - 8, 0), 32);
        const int qc = 16 * nb + fr, wlo = min(max(qc - 8, 0), 48);
        const bf16_t* Qr[1] = {QN + (size_t)mq * 384 + h * 64}; bf16_t* Yr[1] = {Yb + (size_t)mq * DM + 256 + h * 64}; const float ms[1] = {-1e30f};
        attn_item<1, 3>(Qr, Yr, ms, 0.f, KN + (size_t)ms0 * 384 + h * 64, VN + (size_t)ms0 * 384 + (size_t)h * 64 * 2048, row0 * 64 + col0, 64, 8,
                        CKN + (size_t)(bl * 256) * 384 + h * 64, CVN + (size_t)(bl * 6 + h) * 64 * 256, 8, 384, 1,
                        rpb + h * 15 * 31, row0 - r + 7, col0, qc, wlo, 0, 0, fr, fq);
    }
}
DI void ph_mix(LAS unsigned char* lds, int l, int wv) { mix_hyena(lds, l, wv); mix_gqa(l, wv); mix_nas(lds, l, wv); mix_nac(l, wv); }

DI void ph_ytrans(LAS unsigned char* lds, int wv) {
    PH_BEGIN
    const bf16_t* YT = (const bf16_t*)(ws + WS_Z + 4 * MiB); bf16_t* Yb = (bf16_t*)(ws + WS_Y);
    LAS unsigned short* tile = (LAS unsigned short*)(lds + wave * 16384);
    const int rr = lane >> 3, s8 = lane & 7;
    for (int it = gw; it < 512; it += NGW) {
        const int c0 = 64 * (it & 3), m0 = 64 * (it >> 2);
        u32x4 v[8];
#pragma unroll
        for (int i = 0; i < 8; ++i) v[i] = *(const u32x4*)(YT + (size_t)(c0 + 8 * i + rr) * NTOK + m0 + 8 * s8);
#pragma unroll
        for (int i = 0; i < 8; ++i) { LAS unsigned short* d = tile + (8 * i + rr) * 66 + 8 * s8;
            d[0] = (unsigned short)(v[i].x & 0xffffu); d[1] = (unsigned short)(v[i].x >> 16); d[2] = (unsigned short)(v[i].y & 0xffffu); d[3] = (unsigned short)(v[i].y >> 16);
            d[4] = (unsigned short)(v[i].z & 0xffffu); d[5] = (unsigned short)(v[i].z >> 16); d[6] = (unsigned short)(v[i].w & 0xffffu); d[7] = (unsigned short)(v[i].w >> 16); }
        asm volatile("s_waitcnt lgkmcnt(0)" ::: "memory");
#pragma unroll
        for (int j = 0; j < 8; ++j) { const int m = 8 * j + rr; const LAS unsigned short* s = tile + (8 * s8) * 66 + m;
            u32x4 o; o.x = (unsigned)s[0] | ((unsigned)s[66] << 16); o.y = (unsigned)s[2 * 66] | ((unsigned)s[3 * 66] << 16);
            o.z = (unsigned)s[4 * 66] | ((unsigned)s[5 * 66] << 16); o.w = (unsigned)s[6 * 66] | ((unsigned)s[7 * 66] << 16);
            *(u32x4*)(Yb + (size_t)(m0 + m) * DM + c0 + 8 * s8) = o; }
        asm volatile("s_waitcnt lgkmcnt(0)" ::: "memory");
    }
}

#define GRID_BAR() do { KP kpb = (KP)__builtin_amdgcn_kernarg_segment_ptr(); asm volatile("" : "+s"(kpb)); \
    XcdBarrier bb; bb.bar = (unsigned*)(kpb->ws + WS_CTL); bb.x = xb_xcc_id(); bb.st = (volatile LAS unsigned*)(lds + MISC_OFF) + 8; unsigned lzb = 0u; asm volatile("" : "+v"(lzb)); xcd_barrier(bb, wv == 0 && __builtin_amdgcn_mbcnt_hi(~0u, __builtin_amdgcn_mbcnt_lo(~0u, lzb)) == 0u); } while (0)

__global__ void __launch_bounds__(512, 2) mega_fwd(Params p) {
    extern __shared__ __attribute__((aligned(16))) unsigned char lds_raw[];
    LAS unsigned char* lds = (LAS unsigned char*)lds_raw;
    cg::grid_group grid = cg::this_grid();
    const int wv = __builtin_amdgcn_readfirstlane(threadIdx.x >> 6);
    if (threadIdx.x < 32) ((volatile LAS unsigned*)(lds + MISC_OFF))[threadIdx.x] = 0u;
    __syncthreads();
    (void)xcd_barrier_post((unsigned*)(p.ws + WS_CTL), (volatile LAS unsigned*)(lds + MISC_OFF) + 8);
    if (p.ws == nullptr) grid.sync();
    phase0(lds, wv);
    GRID_BAR();
#pragma unroll 1
    for (int l = 0; l < 2; ++l) {
#pragma unroll 1
        for (int s = 0; s < 3; ++s) {
            ph_combine(lds, l, s, false, wv);
            GRID_BAR();
            if (s != 1) {
                ph_up(lds, l, s >> 1, wv);
                GRID_BAR();
                ph_part(lds, l, s >> 1, false, wv);
                GRID_BAR();
            } else {
                ph_in(lds, l, wv);
                GRID_BAR();
                ph_post(l, wv);
                GRID_BAR();
                ph_mix(lds, l, wv);
                GRID_BAR();
                ph_ytrans(lds, wv);
                GRID_BAR();
                ph_part(lds, l, 0, true, wv);
                GRID_BAR();
            }
        }
    }
    ph_combine(lds, 1, 2, true, wv);
}

extern "C" void kernel_launch(void* const* d_in, const int* in_sizes, int n_in, void* d_out, int out_size, void* d_ws, size_t ws_size, hipStream_t stream) {
    static int grid_blocks = 0;
    if (grid_blocks == 0) {
        if (n_in != 31 || out_size != 16777216 || ws_size < WS_END) { fprintf(stderr, "kernel_launch: unexpected problem (n_in %d, out %d, ws %zu)\n", n_in, out_size, ws_size); grid_blocks = -1; return; }
        int dev = 0, cus = 0, per_cu = 0;
        hipGetDevice(&dev);
        hipDeviceGetAttribute(&cus, hipDeviceAttributeMultiprocessorCount, dev);
        if (hipFuncSetAttribute((const void*)mega_fwd, hipFuncAttributeMaxDynamicSharedMemorySize, LDS_BYTES) != hipSuccess) { fprintf(stderr, "kernel_launch: hipFuncSetAttribute failed\n"); grid_blocks = -1; return; }
        hipOccupancyMaxActiveBlocksPerMultiprocessor(&per_cu, (const void*)mega_fwd, 512, LDS_BYTES);
        if (per_cu < 1) { fprintf(stderr, "kernel_launch: occupancy query says %d blocks per CU\n", per_cu); per_cu = 1; }
        (void)hipGetLastError();
        grid_blocks = cus;
    }
    if (grid_blocks < 0) return;
    if (hipMemsetAsync((char*)d_ws + WS_CTL, 0, CTL_BYTES, stream) != hipSuccess) { fprintf(stderr, "kernel_launch: memset failed\n"); return; }
    Params p{};
    for (int i = 0; i < 31; ++i) p.in[i] = (const float*)d_in[i];
    p.out = (float*)d_out; p.ws = (unsigned char*)d_ws;
    void* args[] = {&p};
    hipError_t e = hipLaunchCooperativeKernel((const void*)mega_fwd, dim3(grid_blocks), dim3(512), args, LDS_BYTES, stream);
    if (e != hipSuccess) fprintf(stderr, "kernel_launch: cooperative launch failed: %s (grid %d)\n", hipGetErrorString(e), grid_blocks);
}
```

```cpp
#include <hip/hip_runtime.h>
#include <hip/hip_cooperative_groups.h>
#include <cstdint>
#include <cstdio>
namespace cg = cooperative_groups;

#define DI __device__ __forceinline__
#define LAS __attribute__((address_space(3)))
typedef unsigned short bf16_t;
typedef short bf16x8 __attribute__((ext_vector_type(8)));
typedef float f32x4 __attribute__((ext_vector_type(4)));
typedef unsigned u32x4 __attribute__((ext_vector_type(4)));
typedef unsigned u32x2 __attribute__((ext_vector_type(2)));

namespace pg8 {
constexpr int BM = 256, BK = 64, HALF = 128, HTB = HALF * BK * 2, STAGE_BYTES = 8 * HTB, NXCD = 8, WGM = 8;
__host__ __device__ __forceinline__ int lds_byte(int r, int c) { const int st = (r >> 4) * 2 + (c >> 5), rr = r & 15, cc = c & 31, ob = rr * 64 + cc * 2; return st * 1024 + (ob ^ (((ob >> 9) & 1) << 5)); }
__host__ __device__ __forceinline__ void stage_rc(int b, int& R, int& C) { const int st = b / 1024, sb = b % 1024, swz = sb ^ (((sb >> 9) & 1) << 5); R = (st >> 1) * 16 + swz / 64; C = (st & 1) * 32 + (swz % 64) / 2; }
__host__ __device__ __forceinline__ int perm32(int rho) { const int n = rho >> 4, i = rho & 15; return 8 * (i >> 2) + 4 * n + (i & 3); }

struct Unit { int pm, pn; };
struct Gemm { const bf16_t* A; const bf16_t* Bt; int K, Kloop, nN, hyb; };

struct StaticOrder {
    int nM, nN, nwg, G, c;
    __device__ void init(int M, int N, int G_, int c_) { nM = M / BM; nN = N / BM; nwg = nM * nN; G = G_; c = c_; }
    __device__ bool next(int i, Unit& u) const {
        const long L = (long)i * G + c; if (L >= nwg) return false;
        int wgid = (int)L; { const int q = nwg / NXCD, r = nwg % NXCD, xcd = wgid % NXCD, off = wgid / NXCD; wgid = (xcd < r ? xcd * (q + 1) : r * (q + 1) + (xcd - r) * q) + off; }
        const int nig = WGM * nN, gid = wgid / nig, fm = gid * WGM, gsz = (nM - fm) < WGM ? (nM - fm) : WGM;
        u.pm = fm + ((wgid % nig) % gsz); u.pn = (wgid % nig) / gsz; return true;
    }
};

struct InOrder {
    int G, c;
    __device__ bool next(int i, Unit& u) const {
        const int L = i * G + c; if (L >= 384) return false;
        if (L < 256) { const int x = L & 7, w = L >> 3; u.pm = 4 * x + (w & 3); u.pn = w >> 2; } else { const int s = L - 256, x = s & 7, w = s >> 3; u.pm = 4 * x + (w & 3); u.pn = 8 + (w >> 2); }
        return true;
    }
};

__device__ __forceinline__ unsigned cvt_pk_bf16(float lo, float hi) { unsigned r; asm volatile("v_cvt_pk_bf16_f32 %0, %1, %2" : "=v"(r) : "v"(lo), "v"(hi)); return r; }
__device__ __forceinline__ void st16_wt(void* p, u32x4 w) { asm volatile("global_store_dwordx4 %0, %1, off sc1\n\ts_nop 1" :: "v"(p), "v"(w) : "memory"); }
__device__ __forceinline__ float silu_f(float a) { return a * __builtin_amdgcn_rcpf(1.0f + __expf(-a)); }

struct EpiBf16 {
    static constexpr bool PERM = true;
    bf16_t* O; int ldc;
    __device__ __forceinline__ void operator()(const f32x4 (&acc)[2][2][4][2], const Unit& u, int wr, int wc, int fr, int fq) const {
        const int row0 = u.pm * BM + wr * 64 + fr, col0 = u.pn * BM + wc * 32 + 8 * fq;
#pragma unroll
        for (int ai = 0; ai < 2; ++ai)
#pragma unroll
            for (int m = 0; m < 4; ++m) { bf16_t* rowp = O + (size_t)(row0 + ai * HALF + m * 16) * ldc + col0;
#pragma unroll
                for (int bj = 0; bj < 2; ++bj) { const f32x4 v0 = acc[ai][bj][m][0], v1 = acc[ai][bj][m][1];
                    u32x4 w; w.x = cvt_pk_bf16(v0[0], v0[1]); w.y = cvt_pk_bf16(v0[2], v0[3]); w.z = cvt_pk_bf16(v1[0], v1[1]); w.w = cvt_pk_bf16(v1[2], v1[3]);
                    st16_wt(rowp + bj * HALF, w); } }
    }
};
struct EpiInHyb {
    static constexpr bool PERM = true;
    bf16_t* O; bf16_t* P2;
    __device__ __forceinline__ void operator()(const f32x4 (&acc)[2][2][4][2], const Unit& u, int wr, int wc, int fr, int fq) const {
        const int row0 = u.pm * BM + wr * 64 + fr; bf16_t* base; int ldc, col0;
        if (u.pn < 8) { base = O; ldc = 2560; col0 = u.pn * BM + wc * 32 + 8 * fq; }
        else { const int v = u.pn - 8; base = P2 + (size_t)(v >> 1) * 8192 * 512; ldc = 512; col0 = (v & 1) * BM + wc * 32 + 8 * fq; }
#pragma unroll
        for (int ai = 0; ai < 2; ++ai)
#pragma unroll
            for (int m = 0; m < 4; ++m) { bf16_t* rowp = base + (size_t)(row0 + ai * HALF + m * 16) * ldc + col0;
#pragma unroll
                for (int bj = 0; bj < 2; ++bj) { const f32x4 v0 = acc[ai][bj][m][0], v1 = acc[ai][bj][m][1];
                    u32x4 w; w.x = cvt_pk_bf16(v0[0], v0[1]); w.y = cvt_pk_bf16(v0[2], v0[3]); w.z = cvt_pk_bf16(v1[0], v1[1]); w.w = cvt_pk_bf16(v1[2], v1[3]);
                    st16_wt(rowp + bj * HALF, w); } }
    }
};
struct EpiUp {
    static constexpr bool PERM = true;
    bf16_t* O; int ldc;
    __device__ __forceinline__ void operator()(const f32x4 (&acc)[2][2][4][2], const Unit& u, int wr, int wc, int fr, int fq) const {
        const int row0 = u.pm * BM + wr * 64 + fr, col0 = u.pn * HALF + wc * 32 + 8 * fq;
#pragma unroll
        for (int ai = 0; ai < 2; ++ai)
#pragma unroll
            for (int m = 0; m < 4; ++m) { bf16_t* rowp = O + (size_t)(row0 + ai * HALF + m * 16) * ldc + col0;
                const f32x4 a0 = acc[ai][0][m][0], a1 = acc[ai][0][m][1], b0 = acc[ai][1][m][0], b1 = acc[ai][1][m][1];
                u32x4 w;
                w.x = cvt_pk_bf16(silu_f(a0[0]) * b0[0], silu_f(a0[1]) * b0[1]); w.y = cvt_pk_bf16(silu_f(a0[2]) * b0[2], silu_f(a0[3]) * b0[3]);
                w.z = cvt_pk_bf16(silu_f(a1[0]) * b1[0], silu_f(a1[1]) * b1[1]); w.w = cvt_pk_bf16(silu_f(a1[2]) * b1[2], silu_f(a1[3]) * b1[3]);
                st16_wt(rowp, w); }
    }
};
struct EpiPart {
    static constexpr bool PERM = true;
    bf16_t* P; int ldc; int nN; size_t ks_stride;
    __device__ __forceinline__ void operator()(const f32x4 (&acc)[2][2][4][2], const Unit& u, int wr, int wc, int fr, int fq) const {
        const int ks = u.pn / nN, pnr = u.pn - ks * nN;
        const int row0 = u.pm * BM + wr * 64 + fr, col0 = pnr * BM + wc * 32 + 8 * fq;
        bf16_t* base = P + (size_t)ks * ks_stride;
#pragma unroll
        for (int ai = 0; ai < 2; ++ai)
#pragma unroll
            for (int m = 0; m < 4; ++m) { bf16_t* rowp = base + (size_t)(row0 + ai * HALF + m * 16) * ldc + col0;
#pragma unroll
                for (int bj = 0; bj < 2; ++bj) { const f32x4 v0 = acc[ai][bj][m][0], v1 = acc[ai][bj][m][1];
                    u32x4 w; w.x = cvt_pk_bf16(v0[0], v0[1]); w.y = cvt_pk_bf16(v0[2], v0[3]); w.z = cvt_pk_bf16(v1[0], v1[1]); w.w = cvt_pk_bf16(v1[2], v1[3]);
                    st16_wt(rowp + bj * HALF, w); } }
    }
};

template <class Epi, class Sched>
__device__ __forceinline__ void gemm_phase(LAS unsigned char* lds, const Gemm g, const Sched& S, const Epi& E, const int tid) {
    const int wid = __builtin_amdgcn_readfirstlane(tid >> 6), lane = tid & 63, wr = wid >> 2, wc = wid & 3, fr = lane & 15, fq = lane >> 4;
    const int K = g.K;
    unsigned voffA[2], voffB[2];
#pragma unroll
    for (int i = 0; i < 2; ++i) { int R, C; stage_rc(tid * 16 + i * 8192, R, C); const int Rb = Epi::PERM ? ((R & ~31) + perm32(R & 31)) : R;
        voffA[i] = (unsigned)(R * K + C) * 2u; voffB[i] = (unsigned)(Rb * K + C) * 2u; }
    const size_t kstep = (size_t)(BK * 2);
    const size_t hstep = (size_t)HALF * K * 2;
    const size_t tstep = 2 * hstep;
    const size_t ksbytes = (size_t)g.Kloop * 2;
    const unsigned ldsw = (unsigned)wid * 1024u;
    const int aoff = lds_byte(wr * 64 + fr, fq * 8), boff = lds_byte(wc * 32 + fr, fq * 8);
#define PG8_KS(u) (g.hyb ? ((u).pn < 8 ? 0 : (((u).pn - 8) >> 1)) : ((u).pn / g.nN))
#define PG8_CT(u) (g.hyb ? ((u).pn < 8 ? (u).pn : 8 + (((u).pn - 8) & 1)) : ((u).pn % g.nN))
#define PG8_NT(u) (g.hyb ? ((u).pn < 8 ? 2 * g.Kloop / BK : g.Kloop / BK) : g.Kloop / BK)
#define PG8_BASEA(u) ((const char*)g.A + (size_t)(u).pm * tstep + (size_t)PG8_KS(u) * ksbytes)
#define PG8_BASEB(u) ((const char*)g.Bt + (size_t)PG8_CT(u) * tstep + (size_t)PG8_KS(u) * ksbytes)
#define PG8_SA(b, h) (((b) * 2 + (h)) * HTB)
#define PG8_SB(b, h) ((4 + (b) * 2 + (h)) * HTB)
#define PG8_STAGE(bufoff, gbase, voff) do { _Pragma("unroll") for (int _i = 0; _i < 2; ++_i) \
        __builtin_amdgcn_global_load_lds((const unsigned*)((const char*)(gbase) + (voff)[_i]), (LAS unsigned*)(lds + (bufoff) + ldsw + _i * 8192), 16, 0, 0); } while (0)
#define PG8_LDA(dst, b, h) do { _Pragma("unroll") for (int m = 0; m < 4; ++m) _Pragma("unroll") for (int k = 0; k < 2; ++k) dst[m][k] = *(const LAS bf16x8*)(lds + PG8_SA(b, h) + aoff + m * 2048 + k * 1024); } while (0)
#define PG8_LDB(dst, b, h) do { _Pragma("unroll") for (int n = 0; n < 2; ++n) _Pragma("unroll") for (int k = 0; k < 2; ++k) dst[n][k] = *(const LAS bf16x8*)(lds + PG8_SB(b, h) + boff + n * 2048 + k * 1024); } while (0)
#define PG8_MMA(ai, bj, At, Bt) do { __builtin_amdgcn_s_setprio(1); _Pragma("unroll") for (int m = 0; m < 4; ++m) _Pragma("unroll") for (int n = 0; n < 2; ++n) _Pragma("unroll") for (int k = 0; k < 2; ++k) \
        acc[ai][bj][m][n] = __builtin_amdgcn_mfma_f32_16x16x32_bf16(Bt[n][k], At[m][k], acc[ai][bj][m][n], 0, 0, 0); __builtin_amdgcn_s_setprio(0); } while (0)
#define PG8_WAIT_V(n) asm volatile("s_waitcnt vmcnt(" #n ")" ::: "memory")
#define PG8_WAIT_L(n) asm volatile("s_waitcnt lgkmcnt(" #n ")" ::: "memory")
#define PG8_BAR __builtin_amdgcn_s_barrier()
#define PG8_SCHED __builtin_amdgcn_sched_barrier(0)
    Unit cur, nxt; int ui = 0;
    if (!S.next(0, cur)) return;
    f32x4 acc[2][2][4][2];
#pragma unroll
    for (int a = 0; a < 2; ++a)
#pragma unroll
        for (int b = 0; b < 2; ++b)
#pragma unroll
            for (int m = 0; m < 4; ++m)
#pragma unroll
                for (int n = 0; n < 2; ++n) acc[a][b][m][n] = (f32x4){0.f, 0.f, 0.f, 0.f};
    bf16x8 At[4][2], B0[2][2], B1[2][2];
    const char* cA = PG8_BASEA(cur); const char* cB = PG8_BASEB(cur);
    PG8_STAGE(PG8_SB(0, 0), cB, voffB); PG8_STAGE(PG8_SB(0, 1), cB + hstep, voffB); PG8_STAGE(PG8_SA(0, 0), cA, voffA); PG8_STAGE(PG8_SA(0, 1), cA + hstep, voffA);
    if (wr == 1) PG8_BAR;
    PG8_WAIT_V(2); PG8_BAR;
    PG8_STAGE(PG8_SB(1, 0), cB + kstep, voffB); PG8_STAGE(PG8_SA(1, 0), cA + kstep, voffA); PG8_STAGE(PG8_SB(1, 1), cB + hstep + kstep, voffB);
    PG8_WAIT_V(6); PG8_BAR;
    for (;;) {
        const bool has_next = S.next(ui + 1, nxt);
        const char* nA = has_next ? PG8_BASEA(nxt) : cA; const char* nB = has_next ? PG8_BASEB(nxt) : cB;
        const int nt = PG8_NT(cur);
        for (int t = 0; t < nt; t += 2) {
            const bool last = (t == nt - 2);
            const char* a1 = cA + (size_t)(t + 1) * kstep;
            const char* a2 = last ? nA : cA + (size_t)(t + 2) * kstep; const char* b2 = last ? nB : cB + (size_t)(t + 2) * kstep;
            const char* a3 = a2 + kstep; const char* b3 = b2 + kstep;
            PG8_LDB(B0, 0, 0); PG8_LDB(B1, 0, 1); PG8_SCHED; PG8_LDA(At, 0, 0); PG8_STAGE(PG8_SA(1, 1), a1 + hstep, voffA);
            PG8_WAIT_V(8); PG8_WAIT_L(0); PG8_BAR; PG8_MMA(0, 0, At, B0); PG8_MMA(0, 1, At, B1); PG8_BAR; PG8_SCHED;
            PG8_LDA(At, 0, 1); PG8_STAGE(PG8_SB(0, 0), b2, voffB); PG8_STAGE(PG8_SB(0, 1), b2 + hstep, voffB); PG8_STAGE(PG8_SA(0, 0), a2, voffA);
            PG8_WAIT_V(8); PG8_WAIT_L(0); PG8_BAR; PG8_MMA(1, 0, At, B0); PG8_MMA(1, 1, At, B1); PG8_BAR; PG8_SCHED;
            PG8_LDB(B0, 1, 0); PG8_LDB(B1, 1, 1); PG8_SCHED; PG8_LDA(At, 1, 0); PG8_STAGE(PG8_SA(0, 1), a2 + hstep, voffA);
            PG8_WAIT_V(8); PG8_WAIT_L(0); PG8_BAR; PG8_MMA(0, 0, At, B0); PG8_MMA(0, 1, At, B1); PG8_BAR; PG8_SCHED;
            PG8_LDA(At, 1, 1); PG8_STAGE(PG8_SB(1, 0), b3, voffB); PG8_STAGE(PG8_SB(1, 1), b3 + hstep, voffB); PG8_STAGE(PG8_SA(1, 0), a3, voffA);
            PG8_WAIT_V(8); PG8_WAIT_L(0); PG8_BAR; PG8_MMA(1, 0, At, B0); PG8_MMA(1, 1, At, B1); PG8_BAR; PG8_SCHED;
        }
        if (wr == 0) PG8_BAR;
        E(acc, cur, wr, wc, fr, fq);
        if (!has_next) break;
#pragma unroll
        for (int a = 0; a < 2; ++a)
#pragma unroll
            for (int b = 0; b < 2; ++b)
#pragma unroll
                for (int m = 0; m < 4; ++m)
#pragma unroll
                    for (int n = 0; n < 2; ++n) acc[a][b][m][n] = (f32x4){0.f, 0.f, 0.f, 0.f};
        cur = nxt; cA = nA; cB = nB; ++ui;
        if (wr == 1) PG8_BAR;
    }
    PG8_WAIT_V(0);
    PG8_BAR;
#undef PG8_BASEA
#undef PG8_BASEB
#undef PG8_KS
#undef PG8_CT
#undef PG8_NT
#undef PG8_SA
#undef PG8_SB
#undef PG8_STAGE
#undef PG8_LDA
#undef PG8_LDB
#undef PG8_MMA
#undef PG8_WAIT_V
#undef PG8_WAIT_L
#undef PG8_BAR
#undef PG8_SCHED
}
}

constexpr int DM = 1024, NTOK = 8192, NPR = 4096, DFF = 2816, INW = 2560;
constexpr int LDS_BYTES = 147456;
constexpr float EPSF = 1e-6f;
constexpr size_t MiB = 1u << 20;
constexpr size_t WS_WUP = 0;
constexpr size_t WS_W2T = 44 * MiB;
constexpr size_t WS_WIN = 66 * MiB;
constexpr size_t WS_WOUT = 76 * MiB;
constexpr size_t WS_ROPE = 80 * MiB + 524288;
constexpr size_t WS_KF = 81 * MiB;
constexpr size_t WS_CKN = 90 * MiB;
constexpr size_t WS_CVN = WS_CKN + 786432;
constexpr size_t WS_CKG = WS_CVN + 786432;
constexpr size_t WS_CVG = WS_CKG + 262144;
constexpr size_t WS_H = 92 * MiB;
constexpr size_t WS_U = 108 * MiB;
constexpr size_t WS_P = 152 * MiB;
constexpr size_t WS_QN = 152 * MiB, WS_KN = 158 * MiB, WS_VN = 164 * MiB, WS_QG = 170 * MiB, WS_KG = 176 * MiB, WS_VG = 178 * MiB, WS_Z = 180 * MiB, WS_X0 = 188 * MiB;
constexpr size_t WS_Y = 216 * MiB;
constexpr size_t WS_CTL = 232 * MiB, WS_MOD = WS_CTL + 16384, CTL_BYTES = 16384 + 2 * 3 * 9216 * 4;
constexpr size_t WS_KFT = 233 * MiB;
constexpr size_t WS_END = 238 * MiB;

struct Params { const float* in[31]; float* out; unsigned char* ws; };

DI unsigned f2bf(float f) { unsigned u = __float_as_uint(f); return (u + 0x7fffu + ((u >> 16) & 1u)) >> 16; }
DI unsigned pk2(float lo, float hi) { return f2bf(lo) | (f2bf(hi) << 16); }
DI unsigned pk2_fast(float lo, float hi) { return __builtin_amdgcn_perm(__float_as_uint(hi) + 0x8000u, __float_as_uint(lo) + 0x8000u, 0x07060302u); }
DI float bf2f(bf16_t v) { return __uint_as_float(((unsigned)v) << 16); }
DI float wave_sum(float v) {
#pragma unroll
    for (int o = 1; o < 64; o <<= 1) v += __shfl_xor(v, o);
    return v;
}
DI float silu_acc(float a) { return a / (1.0f + expf(-a)); }

DI void transpose_item(const float* W, int N, bf16_t* WT, int K, int k0, int n0, int dst_row0, LAS float* scr, int lane) {
    {
        const int ln4 = lane & 7, rw = lane >> 3;
        f32x4 v[8];
#pragma unroll
        for (int i = 0; i < 8; ++i) v[i] = __builtin_nontemporal_load((const f32x4*)(W + (size_t)(k0 + 8 * i + rw) * N + n0 + 4 * ln4));
#pragma unroll
        for (int i = 0; i < 8; ++i) { LAS float* d = scr + (8 * i + rw) * 33 + 4 * ln4; d[0] = v[i][0]; d[1] = v[i][1]; d[2] = v[i][2]; d[3] = v[i][3]; }
    }
    asm volatile("s_waitcnt lgkmcnt(0)" ::: "memory");
    const int c = lane & 7;
#pragma unroll
    for (int j = 0; j < 4; ++j) { const int n = (lane >> 3) + 8 * j; const LAS float* s = scr + (8 * c) * 33 + n;
        u32x4 o; o.x = pk2(s[0 * 33], s[1 * 33]); o.y = pk2(s[2 * 33], s[3 * 33]); o.z = pk2(s[4 * 33], s[5 * 33]); o.w = pk2(s[6 * 33], s[7 * 33]);
        *(u32x4*)(WT + (size_t)(dst_row0 + n) * K + k0 + 8 * c) = o; }
    asm volatile("s_waitcnt lgkmcnt(0)" ::: "memory");
}

DI void filter_item(const float* w1, const float* b1, const float* w2, const float* b2, const float* w3, const float* fr, int L, int pos, float* KF, int lane) {
    const float tpos = (float)pos / (float)(L - 1);
    float feat = 0.f;
    if (lane == 0) feat = tpos;
    else if (lane <= 32) { const int i = (lane - 1) & 15; const float band = 1e-4f + (15.0f - 1e-4f) * (float)i / 15.0f;
        const float ang = (6.283185307179586f / (float)L) * (float)pos * band; feat = (lane <= 16) ? cosf(ang) : -sinf(ang); }
    float a = b1[lane];
    for (int e = 0; e < 33; ++e) a += __shfl(feat, e) * w1[e * 64 + lane];
    const float hid1 = sinf(fr[lane] * a);
    a = b2[lane];
    for (int j = 0; j < 64; ++j) a += __shfl(hid1, j) * w2[j * 64 + lane];
    const float hid2 = sinf(fr[64 + lane] * a);
    float acc[8];
#pragma unroll
    for (int q = 0; q < 8; ++q) acc[q] = 0.f;
    for (int j = 0; j < 64; ++j) { const float hj = __shfl(hid2, j);
#pragma unroll
        for (int q = 0; q < 8; ++q) acc[q] += hj * w3[j * 512 + q * 64 + lane]; }
    const float min_decay = -3.0701134573253944f, max_decay = -15.350567286626972f;
#pragma unroll
    for (int q = 0; q < 8; ++q) {
        const int c = lane + 64 * (q & 3);
        const float delta = fabsf(min_decay + (max_decay - min_decay) * (float)c / 255.0f);
        const float val = acc[q] * expf(-tpos * delta);
        if (q < 4) KF[(size_t)(L + pos) * 256 + c] = val;
        else if (pos >= 1) KF[(size_t)(L - pos) * 256 + c] = val;
    }
}

DI void combine_norm(const float* xsP, const float* xsS, const bf16_t* Pp, const float* gate, float gfac, float* X,
                     const float* ng, const float* sc, const float* sh, bf16_t* H, int gw, int NGW, int lane) {
    for (int m0 = 4 * gw; m0 < NTOK; m0 += 4 * NGW) {
        const int mi = (m0 < NPR) ? 0 : 1 + ((m0 - NPR) >> 11);
        const float* xr = (m0 < NPR) ? xsP + (size_t)m0 * DM : xsS + (size_t)(m0 - NPR) * DM;
        f32x4 v[4][4]; u32x2 q0[4][4], q1[4][4]; f32x4 gt[4];
#pragma unroll
        for (int r = 0; r < 4; ++r)
#pragma unroll
            for (int j = 0; j < 4; ++j) { const int col = 4 * lane + 256 * j; v[r][j] = *(const f32x4*)(xr + (size_t)r * DM + col);
                if (Pp) { q0[r][j] = *(const u32x2*)(Pp + (size_t)(m0 + r) * DM + col); q1[r][j] = *(const u32x2*)(Pp + (size_t)NTOK * DM + (size_t)(m0 + r) * DM + col); } }
        if (Pp) {
#pragma unroll
            for (int j = 0; j < 4; ++j) gt[j] = *(const f32x4*)(gate + mi * 9216 + 4 * lane + 256 * j) * gfac;
        }
        f32x4 g[4], s1[4], s0[4];
        if (H) {
#pragma unroll
            for (int j = 0; j < 4; ++j) { const int col = 4 * lane + 256 * j; g[j] = *(const f32x4*)(ng + col); s1[j] = *(const f32x4*)(sc + mi * 9216 + col); s0[j] = *(const f32x4*)(sh + mi * 9216 + col); }
        }
        float ss[4];
#pragma unroll
        for (int r = 0; r < 4; ++r) { ss[r] = 0.f;
#pragma unroll
            for (int j = 0; j < 4; ++j) { const int col = 4 * lane + 256 * j;
                if (Pp) { const u32x2 a = q0[r][j], b = q1[r][j];
                    const f32x4 p0 = (f32x4){__uint_as_float(a.x << 16), __uint_as_float(a.x & 0xffff0000u), __uint_as_float(a.y << 16), __uint_as_float(a.y & 0xffff0000u)};
                    const f32x4 p1 = (f32x4){__uint_as_float(b.x << 16), __uint_as_float(b.x & 0xffff0000u), __uint_as_float(b.y << 16), __uint_as_float(b.y & 0xffff0000u)};
                    v[r][j] += gt[j] * (p0 + p1); }
                *(f32x4*)(X + (size_t)(m0 + r) * DM + col) = v[r][j];
                ss[r] += (v[r][j][0] * v[r][j][0] + v[r][j][1] * v[r][j][1]) + (v[r][j][2] * v[r][j][2] + v[r][j][3] * v[r][j][3]); } }
        if (H) {
#pragma unroll
            for (int o = 1; o < 64; o <<= 1) {
#pragma unroll
                for (int r = 0; r < 4; ++r) ss[r] += __shfl_xor(ss[r], o); }
#pragma unroll
            for (int r = 0; r < 4; ++r) { const float rr = rsqrtf(ss[r] * (1.0f / DM) + EPSF);
#pragma unroll
                for (int j = 0; j < 4; ++j) { const int col = 4 * lane + 256 * j;
                    const f32x4 h = (v[r][j] * rr) * g[j] * (1.0f + s1[j]) + s0[j];
                    u32x2 w; w.x = pk2(h[0], h[1]); w.y = pk2(h[2], h[3]);
                    *(u32x2*)(H + (size_t)(m0 + r) * DM + col) = w; } }
        }
    }
}

#define MFMA16(a, b, c) __builtin_amdgcn_mfma_f32_16x16x32_bf16((a), (b), (c), 0, 0, 0)
DI void fa_load(bf16x8 (&kf)[4], bf16x8 (&vf)[4], const bf16_t* Kt, int kst, const bf16_t* Vt, int fr, int fq) {
    const bf16_t* kr0 = Kt + (size_t)(8 * (fr >> 2) + (fr & 3)) * kst + 16 * fq;
    const bf16_t* kr1 = kr0 + (size_t)4 * kst;
    kf[0] = *(const bf16x8*)kr0; kf[1] = *(const bf16x8*)(kr0 + 8); kf[2] = *(const bf16x8*)kr1; kf[3] = *(const bf16x8*)(kr1 + 8);
#pragma unroll
    for (int db = 0; db < 4; ++db) vf[db] = *(const bf16x8*)(Vt + fq * 512 + (16 * db + fr) * 8);
}
DI void fa_scores(float* sv, const bf16x8 (&kf)[4], const bf16x8 (&qf)[2]) {
    f32x4 s0 = (f32x4){0.f, 0.f, 0.f, 0.f}, s1 = (f32x4){0.f, 0.f, 0.f, 0.f};
    s0 = MFMA16(kf[0], qf[0], s0); s1 = MFMA16(kf[2], qf[0], s1); s0 = MFMA16(kf[1], qf[1], s0); s1 = MFMA16(kf[3], qf[1], s1);
    sv[0] = s0[0]; sv[1] = s0[1]; sv[2] = s0[2]; sv[3] = s0[3]; sv[4] = s1[0]; sv[5] = s1[1]; sv[6] = s1[2]; sv[7] = s1[3];
}
template <int NQ, int NBUF>
DI void attn_item(const bf16_t* const (&Qrow)[NQ], bf16_t* const (&Yrow)[NQ], const float (&m0)[NQ], float l0,
                  const bf16_t* Kl, const bf16_t* Vl, int tok0, int tstep, int nloc,
                  const bf16_t* Kc, const bf16_t* Vc, int nctx, int kst, int mode,
                  const LAS float* rp, int drow0, int col0, int qc, int wlo, int kpos0, int qpos, int fr, int fq) {
    bf16x8 qf[NQ][2]; f32x4 o[NQ][4]; float m[NQ], l[NQ];
#pragma unroll
    for (int q = 0; q < NQ; ++q) { qf[q][0] = *(const bf16x8*)(Qrow[q] + 16 * fq); qf[q][1] = *(const bf16x8*)(Qrow[q] + 16 * fq + 8);
#pragma unroll
        for (int db = 0; db < 4; ++db) o[q][db] = (f32x4){0.f, 0.f, 0.f, 0.f};
        m[q] = m0[q]; l[q] = (fq == 0) ? l0 : 0.f; }
    const int nst = nloc + nctx;
    const int p0u = __builtin_amdgcn_readfirstlane(qpos - fr);
    bf16x8 kb[NBUF][4], vb[NBUF][4];
#define FA_LOAD_TILE(T, B) do { const bf16_t* Kp_; const bf16_t* Vp_; \
        if ((T) < nloc) { const int tok_ = tok0 + (T) * tstep; Kp_ = Kl + (size_t)tok_ * kst; Vp_ = Vl + (size_t)(tok_ >> 3) * 512; } \
        else { const int i_ = (T) - nloc; Kp_ = Kc + (size_t)(32 * i_) * kst; Vp_ = Vc + (size_t)i_ * 2048; } \
        fa_load(kb[B], vb[B], Kp_, kst, Vp_, fr, fq); } while (0)
#pragma unroll
    for (int b = 0; b < NBUF; ++b) if (b < nst) FA_LOAD_TILE(b, b);
    for (int s0 = 0; s0 < nst; s0 += NBUF) {
#pragma unroll
        for (int b = 0; b < NBUF; ++b) {
            const int st = s0 + b;
            if (st < nst) {
#pragma unroll
                for (int q = 0; q < NQ; ++q) {
                    float sv[8];
                    fa_scores(sv, kb[b], qf[q]);
                    if (st < nloc) {
                        if (mode == 1) {
                            const LAS float* rpr = rp + (drow0 + st) * 31;
#pragma unroll
                            for (int jj = 0; jj < 8; ++jj) { const int kcol = col0 + 8 * fq + jj; const bool ok = (kcol >= wlo) && (kcol < wlo + 16);
                                const int dc = min(max(kcol - qc, -15), 15);
                                sv[jj] = ok ? sv[jj] + rpr[dc + 15] : -INFINITY; }
                        } else if (mode == 2 && (kpos0 + 32 * st + 31 - p0u > 128 || kpos0 + 32 * st - (p0u + 15) < -128)) {
#pragma unroll
                            for (int jj = 0; jj < 8; ++jj) { const int dd = kpos0 + 32 * st + 8 * fq + jj - qpos; if (dd > 128 || dd < -128) sv[jj] = -INFINITY; }
                        }
                    }
                    float mx = fmaxf(fmaxf(fmaxf(sv[0], sv[1]), fmaxf(sv[2], sv[3])), fmaxf(fmaxf(sv[4], sv[5]), fmaxf(sv[6], sv[7])));
                    mx = fmaxf(mx, __shfl_xor(mx, 16)); mx = fmaxf(mx, __shfl_xor(mx, 32));
                    const float mn = fmaxf(m[q], mx), alpha = __expf(m[q] - mn);
                    float rs = 0.f;
#pragma unroll
                    for (int j = 0; j < 8; ++j) { sv[j] = __expf(sv[j] - mn); rs += sv[j]; }
                    l[q] = l[q] * alpha + rs; m[q] = mn;
                    u32x4 pw; pw.x = pk2_fast(sv[0], sv[1]); pw.y = pk2_fast(sv[2], sv[3]); pw.z = pk2_fast(sv[4], sv[5]); pw.w = pk2_fast(sv[6], sv[7]);
                    const bf16x8 pf = __builtin_bit_cast(bf16x8, pw);
#pragma unroll
                    for (int db = 0; db < 4; ++db) { o[q][db] = o[q][db] * alpha; o[q][db] = MFMA16(vb[b][db], pf, o[q][db]); }
                }
                if (st + NBUF < nst) FA_LOAD_TILE(st + NBUF, b);
            }
        }
    }
#undef FA_LOAD_TILE
#pragma unroll
    for (int q = 0; q < NQ; ++q) {
        float lq = l[q]; lq += __shfl_xor(lq, 16); lq += __shfl_xor(lq, 32);
        const float inv = 1.0f / lq;
#pragma unroll
        for (int db = 0; db < 4; ++db) { u32x2 w; w.x = pk2(o[q][db][0] * inv, o[q][db][1] * inv); w.y = pk2(o[q][db][2] * inv, o[q][db][3] * inv);
            *(u32x2*)(Yrow[q] + 16 * db + 4 * fq) = w; }
    }
}

DI void hyena_block(LAS unsigned char* lds, int tid, int c, int L, bool sample, const bf16_t* KFTx  , const bf16_t* ZT, const bf16_t* X0T, bf16_t* YT, float sk) {
    const int lane = tid & 63, wave = __builtin_amdgcn_readfirstlane(tid >> 6), fr = lane & 15, fq = lane >> 4;
    const int CP = (2 * L + 16) * 2, ZL = 3 * L;
    constexpr int ZOFF = 8 * 8224;
    __syncthreads();
    {
        const bf16_t* kft = KFTx + (size_t)c * 2 * L;
        const bool has_t = 8 * tid < 2 * L;
        u32x4 tv = (u32x4){0u, 0u, 0u, 0u};
        if (has_t) tv = *(const u32x4*)(kft + 8 * tid);
        const int tpb = L >> 3, zb = tid / tpb, zs0 = 8 * (tid - zb * tpb);
        const int zm0 = sample ? NPR + zb * 2048 : zb * 256;
        const u32x4 zv = *(const u32x4*)(ZT + (size_t)zm0 * 256 + (size_t)c * L + zs0);
#pragma unroll
        for (int k = 0; k < 2; ++k) { const int e0 = 8 * (tid + 512 * k), pb = e0 / (2 * L), off = e0 - pb * 2 * L, pos = off < L ? off : off + L;
            *(LAS u32x4*)(lds + ZOFF + 2 * (pb * ZL + pos)) = (u32x4){0u, 0u, 0u, 0u}; }
        *(LAS u32x4*)(lds + ZOFF + 2 * (zb * ZL + L + zs0)) = zv;
        if (has_t) {
            const unsigned tw[4] = {tv.x, tv.y, tv.z, tv.w};
#pragma unroll
            for (int k = 0; k < 8; ++k) { const int ee = 8 * tid + k; const unsigned short v = (unsigned short)((k & 1) ? (tw[k >> 1] >> 16) : (tw[k >> 1] & 0xffffu));
                if (ee >= 1) { const int x = 2 * L - ee;
#pragma unroll
                    for (int r = 0; r < 8; ++r) *(LAS unsigned short*)(lds + r * CP + 2 * (x + r)) = v; } }
        }
    }
    __syncthreads();
    const int nb = L >> 5;
    const int Ibase = sample ? 8 * wave : 0, bbase = sample ? 0 : 2 * wave;
    const int I = Ibase + (fr & 7), b = bbase + (fr >> 3);
    const int Dlo = max(Ibase - (nb - 1), -(nb - 1)), Dhi = min(Ibase + 7, nb - 1);
    f32x4 acc0 = (f32x4){0.f, 0.f, 0.f, 0.f}, acc1 = acc0;
    const int abase = (fr & 7) * CP + 2 * (L - 8 * (fr >> 3) + 8 * fq);
    const int bbyte = ZOFF + 2 * (b * ZL + L + 32 * I + 8 * fq);
#pragma unroll 4
    for (int D = Dlo; D <= Dhi; ++D) {
        const bf16x8 a0 = *(const LAS bf16x8*)(lds + abase - 64 * D);
        const bf16x8 a1 = *(const LAS bf16x8*)(lds + abase - 64 * D - 32);
        const bf16x8 bfr = *(const LAS bf16x8*)(lds + bbyte - 64 * D);
        acc0 = MFMA16(a0, bfr, acc0); acc1 = MFMA16(a1, bfr, acc1);
    }
    const int mb = sample ? NPR + b * 2048 : b * 256;
#pragma unroll
    for (int ib = 0; ib < 2; ++ib) {
        const int t = 32 * I + 16 * ib + 4 * fq;
        const u32x2 zz = *(const LAS u32x2*)(lds + ZOFF + 2 * (b * ZL + L + t));
        const u32x2 xx = *(const u32x2*)(X0T + (size_t)mb * 256 + (size_t)c * L + t);
        const float zf[4] = {__uint_as_float(zz.x << 16), __uint_as_float(zz.x & 0xffff0000u), __uint_as_float(zz.y << 16), __uint_as_float(zz.y & 0xffff0000u)};
        const float xf[4] = {__uint_as_float(xx.x << 16), __uint_as_float(xx.x & 0xffff0000u), __uint_as_float(xx.y << 16), __uint_as_float(xx.y & 0xffff0000u)};
        float y[4];
#pragma unroll
        for (int i = 0; i < 4; ++i) { const float a = ib ? acc1[i] : acc0[i]; y[i] = (a + zf[i] * sk) * xf[i]; }
        u32x2 w; w.x = pk2(y[0], y[1]); w.y = pk2(y[2], y[3]);
        *(u32x2*)(YT + (size_t)c * NTOK + mb + t) = w;
    }
}

#define XB_TMO      128
#define XB_XCNT(j)  (256  + 64 * (j))
#define XB_XSUB(j)  (1280 + 64 * (j))
#define XB_XGEN(j)  (2304 + 64 * (j))
#define XB_TOP      3328
#define XB_TOPGEN   3392
#define XCD_BAR_WORDS 3456
#define XB_SPIN_CAP (1u << 22)
DI unsigned xb_ld(unsigned* p)              { return __hip_atomic_load(p, __ATOMIC_RELAXED, __HIP_MEMORY_SCOPE_AGENT); }
DI unsigned xb_add(unsigned* p, unsigned v) { return __hip_atomic_fetch_add(p, v, __ATOMIC_RELAXED, __HIP_MEMORY_SCOPE_AGENT); }
DI unsigned xb_xcc_id() { return (unsigned)__builtin_amdgcn_s_getreg((3 << 11) | 20) & 0xFu; }
#define XB_SPIN(cond, bar) do { unsigned _sp = 0; while (cond) { __builtin_amdgcn_s_sleep(1); \
    if ((++_sp & 255u) == 0u) { if (xb_ld(&(bar)[XB_TMO])) break; if (_sp > XB_SPIN_CAP) { atomicAdd(&(bar)[XB_TMO], 1u); break; } } } } while (0)
struct XcdBarrier { unsigned* bar; unsigned x; volatile LAS unsigned* st; };
DI XcdBarrier xcd_barrier_post(unsigned* bar, volatile LAS unsigned* st) {
    XcdBarrier b; b.bar = bar; b.x = xb_xcc_id(); b.st = st;
    if (threadIdx.x == 0) (void)xb_add(&bar[XB_XCNT(b.x)], 1u);
    return b;
}
DI void xcd_barrier_complete(unsigned* bar, unsigned x, unsigned& nloc, unsigned& nx) {
    const unsigned G = gridDim.x * gridDim.y * gridDim.z;
    unsigned sum, cnt, mine, sp = 0u;
    for (;;) {
        sum = 0u; cnt = 0u; mine = 0u;
#pragma unroll
        for (unsigned j = 0; j < 16; ++j) { const unsigned c = xb_ld(&bar[XB_XCNT(j)]); sum += c; cnt += (c > 0u) ? 1u : 0u; mine = (j == x) ? c : mine; }
        if (sum == G) break;
        __builtin_amdgcn_s_sleep(1);
        if ((++sp & 255u) == 0u) { if (xb_ld(&bar[XB_TMO])) break; if (sp > XB_SPIN_CAP) { atomicAdd(&bar[XB_TMO], 1u); break; } }
    }
    nloc = mine > 0u ? mine : 1u; nx = cnt > 0u ? cnt : 1u;
}
DI void xcd_barrier(const XcdBarrier& b, const bool leader) {
    asm volatile("s_waitcnt vmcnt(0)" ::: "memory");
    __syncthreads();
    if (leader) {
        unsigned* bar = b.bar;
        __builtin_amdgcn_s_waitcnt(0);
        unsigned nloc = b.st[0], nx = b.st[1];
        if (nloc == 0u) { xcd_barrier_complete(bar, b.x, nloc, nx); b.st[0] = nloc; b.st[1] = nx; }
        const unsigned old = xb_add(&bar[XB_XSUB(b.x)], 1u);
        const unsigned gen = old / nloc;
        if (old + 1u == (gen + 1u) * nloc) {
            __builtin_amdgcn_fence(__ATOMIC_RELEASE, "agent");
            asm volatile("s_waitcnt vmcnt(0)" ::: "memory");
            const unsigned og = xb_add(&bar[XB_TOP], 1u);
            const unsigned tg = og / nx;
            if (og + 1u == (tg + 1u) * nx) xb_add(&bar[XB_TOPGEN], 1u);
            else XB_SPIN(xb_ld(&bar[XB_TOPGEN]) == tg, bar);
            __builtin_amdgcn_fence(__ATOMIC_ACQUIRE, "agent");
            xb_add(&bar[XB_XGEN(b.x)], 1u);
            asm volatile("s_waitcnt vmcnt(0)" ::: "memory");
        } else {
            XB_SPIN(xb_ld(&bar[XB_XGEN(b.x)]) == gen, bar);
            __builtin_amdgcn_fence(__ATOMIC_ACQUIRE, "agent");
            asm volatile("s_waitcnt vmcnt(0)" ::: "memory");
        }
    }
    __syncthreads();
}
constexpr int MISC_OFF = 131072 + 320;

typedef const __attribute__((address_space(4))) Params* KP;
#define PH_BEGIN \
    KP kp = (KP)__builtin_amdgcn_kernarg_segment_ptr(); asm volatile("" : "+s"(kp)); \
    unsigned lz_ = 0u; asm volatile("" : "+v"(lz_));     \
    int tid = wv * 64 + (int)__builtin_amdgcn_mbcnt_hi(~0u, __builtin_amdgcn_mbcnt_lo(~0u, lz_)); \
    const int lane = tid & 63, wave = __builtin_amdgcn_readfirstlane(tid >> 6), bid = blockIdx.x, NB = gridDim.x; \
    const int gw = bid * 8 + wave, NGW = NB * 8; \
    unsigned char* ws = kp->ws; (void)lane; (void)gw; (void)NGW; (void)ws;

DI void convert_item(KP kp, unsigned char* ws, int it, LAS float* scr, int lane) {
    const int l = it / 10240; const int r = it % 10240;
    if (r < 8448) { const int j = r / 1408, r2 = r % 1408;
        if (j < 4) { const int f = j & 1, w3 = j >> 1;
            const float* W = (w3 ? kp->in[12] : kp->in[11]) + (size_t)(l * 2 + f) * 1024 * 2816;
            const int kb = r2 / 88, nb = r2 % 88, n0 = 32 * nb;
            transpose_item(W, 2816, (bf16_t*)(ws + WS_WUP) + (size_t)(l * 2 + f) * 5632 * 1024, 1024, 64 * kb, n0, 256 * (n0 >> 7) + 128 * w3 + (n0 & 127), scr, lane);
        } else { const int f = j - 4; const float* W = kp->in[13] + (size_t)(l * 2 + f) * 2816 * 1024;
            const int kb = r2 / 32, nb = r2 % 32;
            transpose_item(W, 1024, (bf16_t*)(ws + WS_W2T) + (size_t)(l * 2 + f) * 1024 * 2816, 2816, 64 * kb, 32 * nb, 32 * nb, scr, lane); }
    } else if (r < 9728) { const int r2 = r - 8448, kb = r2 / 80, nb = r2 % 80;
        transpose_item(kp->in[14] + (size_t)l * 1024 * 2560, 2560, (bf16_t*)(ws + WS_WIN) + (size_t)l * 2560 * 1024, 1024, 64 * kb, 32 * nb, 32 * nb, scr, lane);
    } else { const int r2 = r - 9728, kb = r2 / 32, nb = r2 % 32;
        transpose_item(kp->in[15] + (size_t)l * 1024 * 1024, 1024, (bf16_t*)(ws + WS_WOUT) + (size_t)l * 1024 * 1024, 1024, 64 * kb, 32 * nb, 32 * nb, scr, lane); }
}
DI void convert_segs(KP kp, unsigned char* ws, LAS unsigned char* lds, int wave, int lane, int widx, int nw, int s0, int c0, int s1, int c1, int s2, int c2) {
    LAS float* scr = (LAS float*)(lds + wave * 16384);
    const int total = c0 + c1 + c2;
    for (int q = widx; q < total; q += nw) { const int it = q < c0 ? s0 + q : (q < c0 + c1 ? s1 + (q - c0) : s2 + (q - c0 - c1)); convert_item(kp, ws, it, scr, lane); }
}

DI void phase0(LAS unsigned char* lds, int wv) {
    PH_BEGIN
    const int gtid = bid * 512 + tid, NGT = NB * 512;
    float* MOD = (float*)(ws + WS_MOD);
    {
        const float* cctx = kp->in[7]; const float* cs = kp->in[6]; const float* ab = kp->in[9];
        LAS float* sl = (LAS float*)(lds + 131072 + 1024);
        for (int i = tid; i < 3072; i += 512) sl[i] = silu_acc(i < 1024 ? cctx[i] : cs[i - 1024]);
        __syncthreads();
        LAS float* red = (LAS float*)lds;
        for (int it = gw; it < 2304; it += NGW) {
            const int itb = it - wave, l = itb / 1152, r = itb % 1152, cgp = r >> 5, kc = (r & 31) + wave, col = 256 * cgp + 4 * lane;
            const float* aw = kp->in[8] + (size_t)l * 1024 * 9216 + (size_t)(32 * kc) * 9216 + col;
            f32x4 a0 = (f32x4){0.f, 0.f, 0.f, 0.f}, a1 = a0, a2 = a0;
#pragma unroll
            for (int k = 0; k < 32; ++k) {
                const f32x4 wv = __builtin_nontemporal_load((const f32x4*)(aw + (size_t)k * 9216));
                const float s0 = sl[32 * kc + k], s1 = sl[1024 + 32 * kc + k], s2 = sl[2048 + 32 * kc + k];
                a0 += s0 * wv; a1 += s1 * wv; a2 += s2 * wv;
            }
            *(LAS f32x4*)(red + (wave * 3 + 0) * 256 + 4 * lane) = a0; *(LAS f32x4*)(red + (wave * 3 + 1) * 256 + 4 * lane) = a1; *(LAS f32x4*)(red + (wave * 3 + 2) * 256 + 4 * lane) = a2;
            __syncthreads();
            for (int o = tid; o < 768; o += 512) { const int mi = o >> 8, cc = o & 255;
                float sacc = ((r & 31) == 0) ? ab[l * 9216 + 256 * cgp + cc] : 0.f;
#pragma unroll
                for (int w = 0; w < 8; ++w) sacc += red[(w * 3 + mi) * 256 + cc];
                unsafeAtomicAdd(MOD + (size_t)(l * 3 + mi) * 9216 + 256 * cgp + cc, sacc); }
            __syncthreads();
        }
    }
    LAS float* scr = (LAS float*)(lds + wave * 16384);
    if (NB == 256) convert_segs(kp, ws, lds, wave, lane, (gw + NGW - 256) % NGW, NGW, 0, 1408, 2816, 1408, 0, 0);
    else convert_segs(kp, ws, lds, wave, lane, gw, NGW, 0, 20480, 0, 0, 0, 0);
    for (int it = (NB == 256) ? (gw + NGW - 1024) % NGW : gw; it < 4608; it += NGW) {
        const int l = it / 2304, r = it % 2304;
        float* KFl = (float*)(ws + WS_KF) + (size_t)l * 1179648;
        const float* w1 = kp->in[18] + (size_t)l * 33 * 64; const float* b1 = kp->in[19] + l * 64;
        const float* w2 = kp->in[20] + (size_t)l * 64 * 64; const float* b2 = kp->in[21] + l * 64;
        const float* w3 = kp->in[22] + (size_t)l * 64 * 512; const float* frq = kp->in[23] + l * 128;
        if (r < 256) filter_item(w1, b1, w2, b2, w3, frq, 256, r, KFl, lane);
        else filter_item(w1, b1, w2, b2, w3, frq, 2048, r - 256, KFl + 131072, lane);
    }
    {
        bf16_t* CKN = (bf16_t*)(ws + WS_CKN); bf16_t* CVN = (bf16_t*)(ws + WS_CVN); bf16_t* CKG = (bf16_t*)(ws + WS_CKG); bf16_t* CVG = (bf16_t*)(ws + WS_CVG);
        const float* cnk = kp->in[2]; const float* cnv = kp->in[3]; const float* cgk = kp->in[4]; const float* cgv = kp->in[5];
        for (int i = gtid; i < 393216; i += NGT) {
            CKN[i] = (bf16_t)f2bf(cnk[i]);
            const int kk = i & 7, d = (i >> 3) & 63, kg = (i >> 9) & 31, key = 8 * kg + kk, h = (i >> 14) % 6, bl = i / 98304;
            CVN[i] = (bf16_t)f2bf(cnv[((size_t)(bl * 256 + key) * 6 + h) * 64 + d]);
        }
        float* ROPE = (float*)(ws + WS_ROPE);
        for (int i = gtid; i < 65536; i += NGT) { const int t = i >> 5, k = i & 31;
            const float ang = (float)(k < 16 ? (t >> 6) : (t & 63)) * expf(-(float)(k & 15) * (9.210340371976184f / 16.0f));
            ROPE[2 * i] = cosf(ang); ROPE[2 * i + 1] = sinf(ang); }
        for (int i = gtid; i < 131072; i += NGT) {
            CKG[i] = (bf16_t)f2bf(cgk[i]);
            const int kk = i & 7, d = (i >> 3) & 63, kg = (i >> 9) & 31, key = 8 * kg + kk, h = (i >> 14) & 1, bl = i >> 15;
            CVG[i] = (bf16_t)f2bf(cgv[((size_t)(bl * 256 + key) * 2 + h) * 64 + d]);
        }
    }
}

DI void ph_combine(LAS unsigned char* lds, int l, int s, bool fin, int wv) {
    PH_BEGIN
    float* MOD = (float*)(ws + WS_MOD); float* X = kp->out; const bf16_t* Pb = (const bf16_t*)(ws + WS_P); bf16_t* Hb = (bf16_t*)(ws + WS_H);
    if (fin) { combine_norm(X, X + (size_t)NPR * DM, Pb, MOD + (size_t)3 * 9216 + 8 * 1024, 0.5f, X, nullptr, nullptr, nullptr, nullptr, gw, NGW, lane); return; }
    const float* MODl = MOD + (size_t)l * 3 * 9216;
    const bool first = (l == 0 && s == 0);
    const float* gate = first ? nullptr : (s == 0 ? MOD + (size_t)(l - 1) * 3 * 9216 + 8 * 1024 : MODl + (s == 1 ? 2 : 5) * 1024);
    const float gfac = (s == 2) ? 1.0f : 0.5f;
    combine_norm(first ? kp->in[0] : X, first ? kp->in[1] : X + (size_t)NPR * DM, first ? nullptr : Pb, gate, gfac, X,
                 kp->in[10] + (size_t)(l * 3 + s) * 1024, MODl + (3 * s + 1) * 1024, MODl + (3 * s) * 1024, Hb, gw, NGW, lane);
    if (l == 1 && s == 0 && NB == 256) convert_segs(kp, ws, lds, wave, lane, gw, NGW, 10240 + 2816 + 256, 1152, 0, 0, 0, 0);
    if (first) {
        LAS float* scr = (LAS float*)(lds + wave * 16384);
        for (int it = gw; it < 1152; it += NGW) { const int ll = it / 576, r = it % 576;
            const float* KFl = (const float*)(ws + WS_KF) + (size_t)ll * 1179648; bf16_t* KFTl = (bf16_t*)(ws + WS_KFT) + (size_t)ll * 1179648;
            if (r < 64) transpose_item(KFl, 256, KFTl, 512, 64 * (r >> 3), 32 * (r & 7), 32 * (r & 7), scr, lane);
            else { const int r2 = r - 64; transpose_item(KFl + 131072, 256, KFTl + 131072, 4096, 64 * (r2 >> 3), 32 * (r2 & 7), 32 * (r2 & 7), scr, lane); } }
    }
}

DI void ph_up(LAS unsigned char* lds, int l, int f, int wv) {
    PH_BEGIN
    pg8::Gemm g{(const bf16_t*)(ws + WS_H), (const bf16_t*)(ws + WS_WUP) + (size_t)(l * 2 + f) * 5632 * 1024, 1024, 1024, 22, 0};
    pg8::StaticOrder S; S.init(NTOK, 5632, NB, bid);
    pg8::EpiUp E{(bf16_t*)(ws + WS_U), DFF};
    pg8::gemm_phase<pg8::EpiUp, pg8::StaticOrder>(lds, g, S, E, tid);
    if (NB == 256 && bid >= 192) {
        const int w = (bid - 192) * 8 + wave, L = 10240 * l;
        if (f == 0) convert_segs(kp, ws, lds, wave, lane, w, 512, L + 5632, 1408, L + 8448, 1280, 0, 0);
        else if (l == 0) convert_segs(kp, ws, lds, wave, lane, w, 512, 7040, 1408, 10240, 1408, 10240 + 2816, 256);
        else convert_segs(kp, ws, lds, wave, lane, w, 512, L + 7040, 1408, 0, 0, 0, 0);
    }
}
DI void ph_part(LAS unsigned char* lds, int l, int f, bool is_out, int wv) {
    PH_BEGIN
    pg8::Gemm g;
    if (is_out) g = pg8::Gemm{(const bf16_t*)(ws + WS_Y), (const bf16_t*)(ws + WS_WOUT) + (size_t)l * 1024 * 1024, 1024, 512, 4, 0};
    else g = pg8::Gemm{(const bf16_t*)(ws + WS_U), (const bf16_t*)(ws + WS_W2T) + (size_t)(l * 2 + f) * 1024 * 2816, 2816, 1408, 4, 0};
    pg8::StaticOrder S; S.init(NTOK, 2048, NB, bid);
    pg8::EpiPart E{(bf16_t*)(ws + WS_P), DM, 4, (size_t)NTOK * DM};
    pg8::gemm_phase<pg8::EpiPart, pg8::StaticOrder>(lds, g, S, E, tid);
}
DI void ph_in(LAS unsigned char* lds, int l, int wv) {
    PH_BEGIN
    pg8::Gemm g{(const bf16_t*)(ws + WS_H), (const bf16_t*)(ws + WS_WIN) + (size_t)l * 2560 * 1024, 1024, 512, 10, 1};
    pg8::InOrder S{NB, bid};
    pg8::EpiInHyb E{(bf16_t*)(ws + WS_U), (bf16_t*)(ws + WS_Y)};
    pg8::gemm_phase<pg8::EpiInHyb, pg8::InOrder>(lds, g, S, E, tid);
    if (NB == 256 && bid >= 128) { const int L = 10240 * l;
        convert_segs(kp, ws, lds, wave, lane, (bid - 128) * 8 + wave, 1024, L + 9728, 512, L + 1408, 1408, L + 4224, 1408); }
}

DI void unpack8(float (&f)[8], const u32x4 w) {
    f[0] = __uint_as_float(w.x << 16); f[1] = __uint_as_float(w.x & 0xffff0000u); f[2] = __uint_as_float(w.y << 16); f[3] = __uint_as_float(w.y & 0xffff0000u);
    f[4] = __uint_as_float(w.z << 16); f[5] = __uint_as_float(w.z & 0xffff0000u); f[6] = __uint_as_float(w.w << 16); f[7] = __uint_as_float(w.w & 0xffff0000u);
}
DI u32x4 pack8(const float (&f)[8]) { u32x4 w; w.x = pk2(f[0], f[1]); w.y = pk2(f[2], f[3]); w.z = pk2(f[4], f[5]); w.w = pk2(f[6], f[7]); return w; }
DI void ph_post(int l, int wv) {
    PH_BEGIN
    const bf16_t* Ub = (const bf16_t*)(ws + WS_U); const bf16_t* P2 = (const bf16_t*)(ws + WS_Y);
    bf16_t* QN = (bf16_t*)(ws + WS_QN); bf16_t* KN = (bf16_t*)(ws + WS_KN); bf16_t* VN = (bf16_t*)(ws + WS_VN);
    bf16_t* QG = (bf16_t*)(ws + WS_QG); bf16_t* KG = (bf16_t*)(ws + WS_KG); bf16_t* VG = (bf16_t*)(ws + WS_VG);
    bf16_t* ZT = (bf16_t*)(ws + WS_Z); bf16_t* X0T = (bf16_t*)(ws + WS_X0);
    const float* ROPE = (const float*)(ws + WS_ROPE);
    float* out_nak = kp->out + 8388608; float* out_nav = out_nak + 3145728; float* out_gk = out_nav + 3145728; float* out_gv = out_gk + 1048576;
    const float* naqg = kp->in[25] + l * 64; const float* nakg = kp->in[26] + l * 64; const float* gqg = kp->in[28] + l * 64; const float* gkg = kp->in[29] + l * 64;
    const float* cw = kp->in[16] + (size_t)l * 3 * 768; const float* cb = kp->in[17] + (size_t)l * 768;
    {
        const int s8 = lane & 7, hl = lane >> 3;
        auto proc = [&](const int m, const int hf, const u32x4 (&raw)[2], const u32x4 (&raw2)[2]) {
            const bool isS = m >= NPR; const int t = isS ? ((m - NPR) & 2047) : (m & 255);
            const size_t ob = isS ? 0 : ((size_t)((m >> 8) * 2 + l) * 256 + t);
#pragma unroll
            for (int k = 0; k < 2; ++k) {
                const int hd = hf * 16 + 8 * k + hl;
                float x[8]; unpack8(x, raw[k]);
                if (hd >= 20) { float x2[8]; unpack8(x2, raw2[k]);
#pragma unroll
                    for (int e = 0; e < 8; ++e) x[e] += x2[e]; }
                float ss = 0.f;
#pragma unroll
                for (int e = 0; e < 8; ++e) ss += x[e] * x[e];
                ss += __shfl_xor(ss, 1); ss += __shfl_xor(ss, 2); ss += __shfl_xor(ss, 4);
                const float r = rsqrtf(ss * (1.0f / 64.0f) + EPSF);
                const bool isq = hd < 6 || (hd >= 18 && hd < 24), isk = (hd >= 6 && hd < 12) || (hd >= 24 && hd < 26), isv = (hd >= 12 && hd < 18) || (hd >= 26 && hd < 28);
                const bool gq = hd >= 18;
                if (isq || isk) {
                    const float* g = (hd < 6 ? naqg : hd < 12 ? nakg : hd < 24 ? gqg : gkg) + 8 * s8;
                    const f32x4 g0 = *(const f32x4*)g, g1 = *(const f32x4*)(g + 4);
                    float y[8];
#pragma unroll
                    for (int e = 0; e < 8; ++e) y[e] = x[e] * r * (e < 4 ? g0[e] : g1[e - 4]);
                    if (isk && !isS) { float* od = (hd < 12) ? out_nak + ob * 384 + (hd - 6) * 64 + 8 * s8 : out_gk + ob * 128 + (hd - 24) * 64 + 8 * s8;
                        *(f32x4*)od = (f32x4){y[0], y[1], y[2], y[3]}; *(f32x4*)(od + 4) = (f32x4){y[4], y[5], y[6], y[7]}; }
                    if (gq && isS) {
                        const float* rt = ROPE + ((size_t)t * 32 + (s8 < 4 ? 0 : 16) + 8 * (s8 & 1)) * 2;
                        const f32x4 c0 = *(const f32x4*)rt, c1 = *(const f32x4*)(rt + 4), c2 = *(const f32x4*)(rt + 8), c3 = *(const f32x4*)(rt + 12);
                        const float cs[16] = {c0[0], c0[1], c0[2], c0[3], c1[0], c1[1], c1[2], c1[3], c2[0], c2[1], c2[2], c2[3], c3[0], c3[1], c3[2], c3[3]};
#pragma unroll
                        for (int e = 0; e < 8; ++e) { const float pr = __shfl_xor(y[e], 2); const float co = cs[2 * e], si = cs[2 * e + 1];
                            y[e] = (s8 & 2) ? (pr * si + y[e] * co) : (y[e] * co - pr * si); }
                    }
                    if (isq) {
#pragma unroll
                        for (int e = 0; e < 8; ++e) y[e] *= 0.125f;
                    }
                    bf16_t* dst = hd < 6 ? QN + (size_t)m * 384 + hd * 64 : hd < 12 ? KN + (size_t)m * 384 + (hd - 6) * 64 : hd < 24 ? QG + (size_t)m * 384 + (hd - 18) * 64 : KG + (size_t)m * 128 + (hd - 24) * 64;
                    *(u32x4*)(dst + 8 * s8) = pack8(y);
                } else if (isv && !isS) {
                    float* od = (hd < 18) ? out_nav + ob * 384 + (hd - 12) * 64 + 8 * s8 : out_gv + ob * 128 + (hd - 26) * 64 + 8 * s8;
                    *(f32x4*)od = (f32x4){x[0], x[1], x[2], x[3]}; *(f32x4*)(od + 4) = (f32x4){x[4], x[5], x[6], x[7]};
                }
            }
        };
        auto ldraw = [&](const int m, const int hf, u32x4 (&raw)[2], u32x4 (&raw2)[2]) {
#pragma unroll
            for (int k = 0; k < 2; ++k) { const int hd = hf * 16 + 8 * k + hl; raw2[k] = (u32x4){0u, 0u, 0u, 0u};
                if (hd < 20) raw[k] = *(const u32x4*)(Ub + (size_t)m * INW + 768 + hd * 64 + 8 * s8);
                else if (hd < 28) { const bf16_t* p = P2 + (size_t)m * 512 + (hd - 20) * 64 + 8 * s8; raw[k] = *(const u32x4*)p; raw2[k] = *(const u32x4*)(p + (size_t)8192 * 512); }
                else raw[k] = (u32x4){0u, 0u, 0u, 0u}; }
        };
        for (int it = gw; it < 2 * NTOK; it += 2 * NGW) {
            const int it2 = it + NGW; const bool has2 = it2 < 2 * NTOK;
            u32x4 rawA[2], rawB[2], rawA2[2], rawB2[2];
            ldraw(it >> 1, it & 1, rawA, rawA2);
            if (has2) ldraw(it2 >> 1, it2 & 1, rawB, rawB2);
            proc(it >> 1, it & 1, rawA, rawA2);
            if (has2) proc(it2 >> 1, it2 & 1, rawB, rawB2);
        }
    }
    for (int it = gw; it < 4096; it += NGW) {
        const int tg = it >> 2, cgp = it & 3, mb = tg * 8, c = 64 * cgp + lane;
        const bool isS = mb >= NPR; const int T = isS ? 2048 : 256;
        const int m0 = isS ? NPR + ((mb - NPR) >> 11) * 2048 : (mb >> 8) * 256, t0 = mb - m0;
        float uc[3][8];
#pragma unroll
        for (int part = 0; part < 3; ++part) { const int cc = c + 256 * part;
            float u[10];
#pragma unroll
            for (int i = 0; i < 10; ++i) { const int tt = t0 - 1 + i; u[i] = (tt >= 0 && tt < T) ? bf2f(Ub[(size_t)(mb - 1 + i) * INW + cc]) : 0.f; }
            const float w0 = cw[cc], w1 = cw[768 + cc], w2 = cw[1536 + cc], bb = cb[cc];
#pragma unroll
            for (int j = 0; j < 8; ++j) uc[part][j] = u[j] * w0 + u[j + 1] * w1 + u[j + 2] * w2 + bb; }
        float z[8];
#pragma unroll
        for (int j = 0; j < 8; ++j) z[j] = uc[1][j] * uc[2][j];
        const size_t off = (size_t)m0 * 256 + (size_t)c * T + t0;
        *(u32x4*)(ZT + off) = pack8(z); *(u32x4*)(X0T + off) = pack8(uc[0]);
    }
    for (int it = gw; it < 8192; it += NGW) {
        const int g8 = it >> 3, hh = it & 7, mb = g8 * 8;
        const bool isS = mb >= NPR; const int T = isS ? 2048 : 256;
        const int m0 = isS ? NPR + ((mb - NPR) >> 11) * 2048 : (mb >> 8) * 256, t0 = mb - m0;
        float v[8];
        if (hh < 6) {
#pragma unroll
            for (int i = 0; i < 8; ++i) v[i] = bf2f(Ub[(size_t)(mb + i) * INW + 1536 + hh * 64 + lane]);
        } else {
#pragma unroll
            for (int i = 0; i < 8; ++i) { const size_t o = (size_t)(mb + i) * 512 + 384 + (hh - 6) * 64 + lane; v[i] = bf2f(P2[o]) + bf2f(P2[o + (size_t)8192 * 512]); }
        }
        bf16_t* dst = hh < 6 ? VN + (size_t)m0 * 384 + (size_t)hh * 64 * T + (size_t)(t0 >> 3) * 512 + lane * 8
                             : VG + (size_t)m0 * 128 + (size_t)(hh - 6) * 64 * T + (size_t)(t0 >> 3) * 512 + lane * 8;
        *(u32x4*)dst = pack8(v);
    }
}

DI void mix_hyena(LAS unsigned char* lds, int l, int wv) {
    PH_BEGIN
    const bf16_t* ZT = (const bf16_t*)(ws + WS_Z); const bf16_t* X0T = (const bf16_t*)(ws + WS_X0); bf16_t* YT = (bf16_t*)(ws + WS_Z + 4 * MiB);
    const bf16_t* KFTl = (const bf16_t*)(ws + WS_KFT) + (size_t)l * 1179648;
    const float* skip = kp->in[24] + l * 256;
    {
        const float* rpb = kp->in[27] + (size_t)l * 6 * 15 * 31; LAS float* rl = (LAS float*)(lds + 98304);
        for (int i = tid; i < 2790; i += 512) rl[i] = rpb[i];
        __syncthreads();
    }
    for (int c = bid; c < 256; c += NB) {
        const float sk = skip[c];
        hyena_block(lds, tid, c, 2048, true, KFTl + 131072, ZT, X0T, YT, sk);
        hyena_block(lds, tid, c, 256, false, KFTl, ZT, X0T, YT, sk);
    }
}
DI void mix_gqa(int l, int wv) {
    PH_BEGIN
    const int vgw = ((NB & 7) == 0 ? (bid & 7) * (NB >> 3) + (bid >> 3) : bid) * 8 + wave;
    const int fr = lane & 15, fq = lane >> 4;
    const bf16_t* QG = (const bf16_t*)(ws + WS_QG); const bf16_t* KG = (const bf16_t*)(ws + WS_KG); const bf16_t* VG = (const bf16_t*)(ws + WS_VG);
    const bf16_t* CKG = (const bf16_t*)(ws + WS_CKG); const bf16_t* CVG = (const bf16_t*)(ws + WS_CVG); bf16_t* Yb = (bf16_t*)(ws + WS_Y);
    const float* sink = kp->in[30] + l * 6;
    for (int rnd = 0; rnd * NGW < 3584; ++rnd) {
        const int j = rnd * NGW + ((rnd & 1) ? NGW - 1 - vgw : vgw);
        if (j >= 1024) continue;
        const bool lat = j < 512;
        int b, hk, qt, mbase, T, tok0, nloc, nctx, kpos0; const bf16_t* Kc; const bf16_t* Vc;
        if (lat) { b = j >> 8; hk = (j >> 7) & 1; qt = j & 127; mbase = NPR + b * 2048; T = 2048;
            const int p0 = 16 * qt, kt_lo = max((p0 - 128) >> 5, 0), kt_hi = min((p0 + 143) >> 5, 63); tok0 = 32 * kt_lo; nloc = kt_hi - kt_lo + 1; nctx = 8; kpos0 = tok0;
            const int bl = b * 2 + l; Kc = CKG + (size_t)(bl * 256) * 128 + hk * 64; Vc = CVG + (size_t)(bl * 2 + hk) * 64 * 256; }
        else { const int idx = j - 512; b = idx >> 5; hk = (idx >> 4) & 1; qt = idx & 15; mbase = b * 256; T = 256; tok0 = 0; nloc = 8; nctx = 0; kpos0 = 0; Kc = nullptr; Vc = nullptr; }
        const int mq = mbase + 16 * qt + fr;
        const bf16_t* Qr[3]; bf16_t* Yr[3]; float ms[3];
#pragma unroll
        for (int q = 0; q < 3; ++q) { const int h = 3 * hk + q; Qr[q] = QG + (size_t)mq * 384 + h * 64; Yr[q] = Yb + (size_t)mq * DM + 640 + h * 64; ms[q] = sink[h]; }
        attn_item<3, 3>(Qr, Yr, ms, 1.f, KG + (size_t)mbase * 128 + hk * 64, VG + (size_t)mbase * 128 + (size_t)hk * 64 * T, tok0, 32, nloc,
                        Kc, Vc, nctx, 128, lat ? 2 : 0, nullptr, 0, 0, 0, 0, kpos0, 16 * qt + fr, fr, fq);
    }
}
DI void mix_nac(int l, int wv) {
    PH_BEGIN
    const int vgw = ((NB & 7) == 0 ? (bid & 7) * (NB >> 3) + (bid >> 3) : bid) * 8 + wave;
    const int fr = lane & 15, fq = lane >> 4;
    const bf16_t* QN = (const bf16_t*)(ws + WS_QN); const bf16_t* KN = (const bf16_t*)(ws + WS_KN); const bf16_t* VN = (const bf16_t*)(ws + WS_VN); bf16_t* Yb = (bf16_t*)(ws + WS_Y);
    for (int rnd = 0; rnd * NGW < 3584; ++rnd) {
        const int j = rnd * NGW + ((rnd & 1) ? NGW - 1 - vgw : vgw);
        if (j < 1024 || j >= 1792) continue;
        const int idx = j - 1024, b = idx / 48, rem = idx % 48, h = rem >> 3, qp = rem & 7, m0 = b * 256;
        const bf16_t* Qr[2]; bf16_t* Yr[2]; const float ms[2] = {-1e30f, -1e30f};
#pragma unroll
        for (int q = 0; q < 2; ++q) { const int mq = m0 + 16 * (2 * qp + q) + fr; Qr[q] = QN + (size_t)mq * 384 + h * 64; Yr[q] = Yb + (size_t)mq * DM + 256 + h * 64; }
        attn_item<2, 4>(Qr, Yr, ms, 0.f, KN + (size_t)m0 * 384 + h * 64, VN + (size_t)m0 * 384 + (size_t)h * 64 * 256, 0, 32, 8,
                        nullptr, nullptr, 0, 384, 0, nullptr, 0, 0, 0, 0, 0, 0, fr, fq);
    }
}
DI void mix_nas(LAS unsigned char* lds, int l, int wv) {
    PH_BEGIN
    const int vgw = ((NB & 7) == 0 ? (bid & 7) * (NB >> 3) + (bid >> 3) : bid) * 8 + wave;
    const int fr = lane & 15, fq = lane >> 4;
    const bf16_t* QN = (const bf16_t*)(ws + WS_QN); const bf16_t* KN = (const bf16_t*)(ws + WS_KN); const bf16_t* VN = (const bf16_t*)(ws + WS_VN);
    const bf16_t* CKN = (const bf16_t*)(ws + WS_CKN); const bf16_t* CVN = (const bf16_t*)(ws + WS_CVN); bf16_t* Yb = (bf16_t*)(ws + WS_Y);
    const LAS float* rpb = (const LAS float*)(lds + 98304);
    for (int rnd = 0; rnd * NGW < 3584; ++rnd) {
        const int j = rnd * NGW + ((rnd & 1) ? NGW - 1 - vgw : vgw);
        if (j < 2048 || j >= 3584) continue;
        const int idx = j - 2048, b = idx / 768, rem = idx % 768, h = rem >> 7, qt = rem & 127, r = qt >> 2, nb = qt & 3;
        const int ms0 = NPR + b * 2048, mq = ms0 + 16 * qt + fr, bl = b * 2 + l;
        const int row0 = min(max(r - 4, 0), 24), col0 = min(max(16 * nb - 8, 0), 32);
        const int qc = 16 * nb + fr, wlo = min(max(qc - 8, 0), 48);
        const bf16_t* Qr[1] = {QN + (size_t)mq * 384 + h * 64}; bf16_t* Yr[1] = {Yb + (size_t)mq * DM + 256 + h * 64}; const float ms[1] = {-1e30f};
        attn_item<1, 3>(Qr, Yr, ms, 0.f, KN + (size_t)ms0 * 384 + h * 64, VN + (size_t)ms0 * 384 + (size_t)h * 64 * 2048, row0 * 64 + col0, 64, 8,
                        CKN + (size_t)(bl * 256) * 384 + h * 64, CVN + (size_t)(bl * 6 + h) * 64 * 256, 8, 384, 1,
                        rpb + h * 15 * 31, row0 - r + 7, col0, qc, wlo, 0, 0, fr, fq);
    }
}
DI void ph_mix(LAS unsigned char* lds, int l, int wv) { mix_hyena(lds, l, wv); mix_gqa(l, wv); mix_nas(lds, l, wv); mix_nac(l, wv); }

DI void ph_ytrans(LAS unsigned char* lds, int wv) {
    PH_BEGIN
    const bf16_t* YT = (const bf16_t*)(ws + WS_Z + 4 * MiB); bf16_t* Yb = (bf16_t*)(ws + WS_Y);
    LAS unsigned short* tile = (LAS unsigned short*)(lds + wave * 16384);
    const int rr = lane >> 3, s8 = lane & 7;
    for (int it = gw; it < 512; it += NGW) {
        const int c0 = 64 * (it & 3), m0 = 64 * (it >> 2);
        u32x4 v[8];
#pragma unroll
        for (int i = 0; i < 8; ++i) v[i] = *(const u32x4*)(YT + (size_t)(c0 + 8 * i + rr) * NTOK + m0 + 8 * s8);
#pragma unroll
        for (int i = 0; i < 8; ++i) { LAS unsigned short* d = tile + (8 * i + rr) * 66 + 8 * s8;
            d[0] = (unsigned short)(v[i].x & 0xffffu); d[1] = (unsigned short)(v[i].x >> 16); d[2] = (unsigned short)(v[i].y & 0xffffu); d[3] = (unsigned short)(v[i].y >> 16);
            d[4] = (unsigned short)(v[i].z & 0xffffu); d[5] = (unsigned short)(v[i].z >> 16); d[6] = (unsigned short)(v[i].w & 0xffffu); d[7] = (unsigned short)(v[i].w >> 16); }
        asm volatile("s_waitcnt lgkmcnt(0)" ::: "memory");
#pragma unroll
        for (int j = 0; j < 8; ++j) { const int m = 8 * j + rr; const LAS unsigned short* s = tile + (8 * s8) * 66 + m;
            u32x4 o; o.x = (unsigned)s[0] | ((unsigned)s[66] << 16); o.y = (unsigned)s[2 * 66] | ((unsigned)s[3 * 66] << 16);
            o.z = (unsigned)s[4 * 66] | ((unsigned)s[5 * 66] << 16); o.w = (unsigned)s[6 * 66] | ((unsigned)s[7 * 66] << 16);
            *(u32x4*)(Yb + (size_t)(m0 + m) * DM + c0 + 8 * s8) = o; }
        asm volatile("s_waitcnt lgkmcnt(0)" ::: "memory");
    }
}

#define GRID_BAR() do { KP kpb = (KP)__builtin_amdgcn_kernarg_segment_ptr(); asm volatile("" : "+s"(kpb)); \
    XcdBarrier bb; bb.bar = (unsigned*)(kpb->ws + WS_CTL); bb.x = xb_xcc_id(); bb.st = (volatile LAS unsigned*)(lds + MISC_OFF) + 8; unsigned lzb = 0u; asm volatile("" : "+v"(lzb)); xcd_barrier(bb, wv == 0 && __builtin_amdgcn_mbcnt_hi(~0u, __builtin_amdgcn_mbcnt_lo(~0u, lzb)) == 0u); } while (0)

__global__ void __launch_bounds__(512, 2) mega_fwd(Params p) {
    extern __shared__ __attribute__((aligned(16))) unsigned char lds_raw[];
    LAS unsigned char* lds = (LAS unsigned char*)lds_raw;
    cg::grid_group grid = cg::this_grid();
    const int wv = __builtin_amdgcn_readfirstlane(threadIdx.x >> 6);
    if (threadIdx.x < 32) ((volatile LAS unsigned*)(lds + MISC_OFF))[threadIdx.x] = 0u;
    __syncthreads();
    (void)xcd_barrier_post((unsigned*)(p.ws + WS_CTL), (volatile LAS unsigned*)(lds + MISC_OFF) + 8);
    if (p.ws == nullptr) grid.sync();
    phase0(lds, wv);
    GRID_BAR();
#pragma unroll 1
    for (int l = 0; l < 2; ++l) {
#pragma unroll 1
        for (int s = 0; s < 3; ++s) {
            ph_combine(lds, l, s, false, wv);
            GRID_BAR();
            if (s != 1) {
                ph_up(lds, l, s >> 1, wv);
                GRID_BAR();
                ph_part(lds, l, s >> 1, false, wv);
                GRID_BAR();
            } else {
                ph_in(lds, l, wv);
                GRID_BAR();
                ph_post(l, wv);
                GRID_BAR();
                ph_mix(lds, l, wv);
                GRID_BAR();
                ph_ytrans(lds, wv);
                GRID_BAR();
                ph_part(lds, l, 0, true, wv);
                GRID_BAR();
            }
        }
    }
    ph_combine(lds, 1, 2, true, wv);
}

extern "C" void kernel_launch(void* const* d_in, const int* in_sizes, int n_in, void* d_out, int out_size, void* d_ws, size_t ws_size, hipStream_t stream) {
    static int grid_blocks = 0;
    if (grid_blocks == 0) {
        if (n_in != 31 || out_size != 16777216 || ws_size < WS_END) { fprintf(stderr, "kernel_launch: unexpected problem (n_in %d, out %d, ws %zu)\n", n_in, out_size, ws_size); grid_blocks = -1; return; }
        int dev = 0, cus = 0, per_cu = 0;
        hipGetDevice(&dev);
        hipDeviceGetAttribute(&cus, hipDeviceAttributeMultiprocessorCount, dev);
        if (hipFuncSetAttribute((const void*)mega_fwd, hipFuncAttributeMaxDynamicSharedMemorySize, LDS_BYTES) != hipSuccess) { fprintf(stderr, "kernel_launch: hipFuncSetAttribute failed\n"); grid_blocks = -1; return; }
        hipOccupancyMaxActiveBlocksPerMultiprocessor(&per_cu, (const void*)mega_fwd, 512, LDS_BYTES);
        if (per_cu < 1) { fprintf(stderr, "kernel_launch: occupancy query says %d blocks per CU\n", per_cu); per_cu = 1; }
        (void)hipGetLastError();
        grid_blocks = cus;
    }
    if (grid_blocks < 0) return;
    if (hipMemsetAsync((char*)d_ws + WS_CTL, 0, CTL_BYTES, stream) != hipSuccess) { fprintf(stderr, "kernel_launch: memset failed\n"); return; }
    Params p{};
    for (int i = 0; i < 31; ++i) p.in[i] = (const float*)d_in[i];
    p.out = (float*)d_out; p.ws = (unsigned char*)d_ws;
    void* args[] = {&p};
    hipError_t e = hipLaunchCooperativeKernel((const void*)mega_fwd, dim3(grid_blocks), dim3(512), args, LDS_BYTES, stream);
    if (e != hipSuccess) fprintf(stderr, "kernel_launch: cooperative launch failed: %s (grid %d)\n", hipGetErrorString(e), grid_blocks);
}
```

```cpp
#include <hip/hip_runtime.h>
#include <hip/hip_cooperative_groups.h>
#include <cstdint>
#include <cstdio>
namespace cg = cooperative_groups;

#define DI __device__ __forceinline__
#define LAS __attribute__((address_space(3)))
typedef unsigned short bf16_t;
typedef short bf16x8 __attribute__((ext_vector_type(8)));
typedef float f32x4 __attribute__((ext_vector_type(4)));
typedef unsigned u32x4 __attribute__((ext_vector_type(4)));
typedef unsigned u32x2 __attribute__((ext_vector_type(2)));

namespace pg8 {
constexpr int BM = 256, BK = 64, HALF = 128, HTB = HALF * BK * 2, STAGE_BYTES = 8 * HTB, NXCD = 8, WGM = 8;
__host__ __device__ __forceinline__ int lds_byte(int r, int c) { const int st = (r >> 4) * 2 + (c >> 5), rr = r & 15, cc = c & 31, ob = rr * 64 + cc * 2; return st * 1024 + (ob ^ (((ob >> 9) & 1) << 5)); }
__host__ __device__ __forceinline__ void stage_rc(int b, int& R, int& C) { const int st = b / 1024, sb = b % 1024, swz = sb ^ (((sb >> 9) & 1) << 5); R = (st >> 1) * 16 + swz / 64; C = (st & 1) * 32 + (swz % 64) / 2; }
__host__ __device__ __forceinline__ int perm32(int rho) { const int n = rho >> 4, i = rho & 15; return 8 * (i >> 2) + 4 * n + (i & 3); }

struct Unit { int pm, pn; };
struct Gemm { const bf16_t* A; const bf16_t* Bt; int K, Kloop, nN, hyb; };

struct StaticOrder {
    int nM, nN, nwg, G, c;
    __device__ void init(int M, int N, int G_, int c_) { nM = M / BM; nN = N / BM; nwg = nM * nN; G = G_; c = c_; }
    __device__ bool next(int i, Unit& u) const {
        const long L = (long)i * G + c; if (L >= nwg) return false;
        int wgid = (int)L; { const int q = nwg / NXCD, r = nwg % NXCD, xcd = wgid % NXCD, off = wgid / NXCD; wgid = (xcd < r ? xcd * (q + 1) : r * (q + 1) + (xcd - r) * q) + off; }
        const int nig = WGM * nN, gid = wgid / nig, fm = gid * WGM, gsz = (nM - fm) < WGM ? (nM - fm) : WGM;
        u.pm = fm + ((wgid % nig) % gsz); u.pn = (wgid % nig) / gsz; return true;
    }
};

struct InOrder {
    int G, c;
    __device__ bool next(int i, Unit& u) const {
        const int L = i * G + c; if (L >= 384) return false;
        if (L < 256) { const int x = L & 7, w = L >> 3; u.pm = 4 * x + (w & 3); u.pn = w >> 2; } else { const int s = L - 256, x = s & 7, w = s >> 3; u.pm = 4 * x + (w & 3); u.pn = 8 + (w >> 2); }
        return true;
    }
};

__device__ __forceinline__ unsigned cvt_pk_bf16(float lo, float hi) { unsigned r; asm volatile("v_cvt_pk_bf16_f32 %0, %1, %2" : "=v"(r) : "v"(lo), "v"(hi)); return r; }
__device__ __forceinline__ void st16_wt(void* p, u32x4 w) { asm volatile("global_store_dwordx4 %0, %1, off sc1\n\ts_nop 1" :: "v"(p), "v"(w) : "memory"); }
__device__ __forceinline__ float silu_f(float a) { return a * __builtin_amdgcn_rcpf(1.0f + __expf(-a)); }

struct EpiBf16 {
    static constexpr bool PERM = true;
    bf16_t* O; int ldc;
    __device__ __forceinline__ void operator()(const f32x4 (&acc)[2][2][4][2], const Unit& u, int wr, int wc, int fr, int fq) const {
        const int row0 = u.pm * BM + wr * 64 + fr, col0 = u.pn * BM + wc * 32 + 8 * fq;
#pragma unroll
        for (int ai = 0; ai < 2; ++ai)
#pragma unroll
            for (int m = 0; m < 4; ++m) { bf16_t* rowp = O + (size_t)(row0 + ai * HALF + m * 16) * ldc + col0;
#pragma unroll
                for (int bj = 0; bj < 2; ++bj) { const f32x4 v0 = acc[ai][bj][m][0], v1 = acc[ai][bj][m][1];
                    u32x4 w; w.x = cvt_pk_bf16(v0[0], v0[1]); w.y = cvt_pk_bf16(v0[2], v0[3]); w.z = cvt_pk_bf16(v1[0], v1[1]); w.w = cvt_pk_bf16(v1[2], v1[3]);
                    st16_wt(rowp + bj * HALF, w); } }
    }
};
struct EpiInHyb {
    static constexpr bool PERM = true;
    bf16_t* O; bf16_t* P2;
    __device__ __forceinline__ void operator()(const f32x4 (&acc)[2][2][4][2], const Unit& u, int wr, int wc, int fr, int fq) const {
        const int row0 = u.pm * BM + wr * 64 + fr; bf16_t* base; int ldc, col0;
        if (u.pn < 8) { base = O; ldc = 2560; col0 = u.pn * BM + wc * 32 + 8 * fq; }
        else { const int v = u.pn - 8; base = P2 + (size_t)(v >> 1) * 8192 * 512; ldc = 512; col0 = (v & 1) * BM + wc * 32 + 8 * fq; }
#pragma unroll
        for (int ai = 0; ai < 2; ++ai)
#pragma unroll
            for (int m = 0; m < 4; ++m) { bf16_t* rowp = base + (size_t)(row0 + ai * HALF + m * 16) * ldc + col0;
#pragma unroll
                for (int bj = 0; bj < 2; ++bj) { const f32x4 v0 = acc[ai][bj][m][0], v1 = acc[ai][bj][m][1];
                    u32x4 w; w.x = cvt_pk_bf16(v0[0], v0[1]); w.y = cvt_pk_bf16(v0[2], v0[3]); w.z = cvt_pk_bf16(v1[0], v1[1]); w.w = cvt_pk_bf16(v1[2], v1[3]);
                    st16_wt(rowp + bj * HALF, w); } }
    }
};
struct EpiUp {
    static constexpr bool PERM = true;
    bf16_t* O; int ldc;
    __device__ __forceinline__ void operator()(const f32x4 (&acc)[2][2][4][2], const Unit& u, int wr, int wc, int fr, int fq) const {
        const int row0 = u.pm * BM + wr * 64 + fr, col0 = u.pn * HALF + wc * 32 + 8 * fq;
#pragma unroll
        for (int ai = 0; ai < 2; ++ai)
#pragma unroll
            for (int m = 0; m < 4; ++m) { bf16_t* rowp = O + (size_t)(row0 + ai * HALF + m * 16) * ldc + col0;
                const f32x4 a0 = acc[ai][0][m][0], a1 = acc[ai][0][m][1], b0 = acc[ai][1][m][0], b1 = acc[ai][1][m][1];
                u32x4 w;
                w.x = cvt_pk_bf16(silu_f(a0[0]) * b0[0], silu_f(a0[1]) * b0[1]); w.y = cvt_pk_bf16(silu_f(a0[2]) * b0[2], silu_f(a0[3]) * b0[3]);
                w.z = cvt_pk_bf16(silu_f(a1[0]) * b1[0], silu_f(a1[1]) * b1[1]); w.w = cvt_pk_bf16(silu_f(a1[2]) * b1[2], silu_f(a1[3]) * b1[3]);
                st16_wt(rowp, w); }
    }
};
struct EpiPart {
    static constexpr bool PERM = true;
    bf16_t* P; int ldc; int nN; size_t ks_stride;
    __device__ __forceinline__ void operator()(const f32x4 (&acc)[2][2][4][2], const Unit& u, int wr, int wc, int fr, int fq) const {
        const int ks = u.pn / nN, pnr = u.pn - ks * nN;
        const int row0 = u.pm * BM + wr * 64 + fr, col0 = pnr * BM + wc * 32 + 8 * fq;
        bf16_t* base = P + (size_t)ks * ks_stride;
#pragma unroll
        for (int ai = 0; ai < 2; ++ai)
#pragma unroll
            for (int m = 0; m < 4; ++m) { bf16_t* rowp = base + (size_t)(row0 + ai * HALF + m * 16) * ldc + col0;
#pragma unroll
                for (int bj = 0; bj < 2; ++bj) { const f32x4 v0 = acc[ai][bj][m][0], v1 = acc[ai][bj][m][1];
                    u32x4 w; w.x = cvt_pk_bf16(v0[0], v0[1]); w.y = cvt_pk_bf16(v0[2], v0[3]); w.z = cvt_pk_bf16(v1[0], v1[1]); w.w = cvt_pk_bf16(v1[2], v1[3]);
                    st16_wt(rowp + bj * HALF, w); } }
    }
};

template <class Epi, class Sched>
__device__ __forceinline__ void gemm_phase(LAS unsigned char* lds, const Gemm g, const Sched& S, const Epi& E, const int tid) {
    const int wid = __builtin_amdgcn_readfirstlane(tid >> 6), lane = tid & 63, wr = wid >> 2, wc = wid & 3, fr = lane & 15, fq = lane >> 4;
    const int K = g.K;
    unsigned voffA[2], voffB[2];
#pragma unroll
    for (int i = 0; i < 2; ++i) { int R, C; stage_rc(tid * 16 + i * 8192, R, C); const int Rb = Epi::PERM ? ((R & ~31) + perm32(R & 31)) : R;
        voffA[i] = (unsigned)(R * K + C) * 2u; voffB[i] = (unsigned)(Rb * K + C) * 2u; }
    const size_t kstep = (size_t)(BK * 2);
    const size_t hstep = (size_t)HALF * K * 2;
    const size_t tstep = 2 * hstep;
    const size_t ksbytes = (size_t)g.Kloop * 2;
    const unsigned ldsw = (unsigned)wid * 1024u;
    const int aoff = lds_byte(wr * 64 + fr, fq * 8), boff = lds_byte(wc * 32 + fr, fq * 8);
#define PG8_KS(u) (g.hyb ? ((u).pn < 8 ? 0 : (((u).pn - 8) >> 1)) : ((u).pn / g.nN))
#define PG8_CT(u) (g.hyb ? ((u).pn < 8 ? (u).pn : 8 + (((u).pn - 8) & 1)) : ((u).pn % g.nN))
#define PG8_NT(u) (g.hyb ? ((u).pn < 8 ? 2 * g.Kloop / BK : g.Kloop / BK) : g.Kloop / BK)
#define PG8_BASEA(u) ((const char*)g.A + (size_t)(u).pm * tstep + (size_t)PG8_KS(u) * ksbytes)
#define PG8_BASEB(u) ((const char*)g.Bt + (size_t)PG8_CT(u) * tstep + (size_t)PG8_KS(u) * ksbytes)
#define PG8_SA(b, h) (((b) * 2 + (h)) * HTB)
#define PG8_SB(b, h) ((4 + (b) * 2 + (h)) * HTB)
#define PG8_STAGE(bufoff, gbase, voff) do { _Pragma("unroll") for (int _i = 0; _i < 2; ++_i) \
        __builtin_amdgcn_global_load_lds((const unsigned*)((const char*)(gbase) + (voff)[_i]), (LAS unsigned*)(lds + (bufoff) + ldsw + _i * 8192), 16, 0, 0); } while (0)
#define PG8_LDA(dst, b, h) do { _Pragma("unroll") for (int m = 0; m < 4; ++m) _Pragma("unroll") for (int k = 0; k < 2; ++k) dst[m][k] = *(const LAS bf16x8*)(lds + PG8_SA(b, h) + aoff + m * 2048 + k * 1024); } while (0)
#define PG8_LDB(dst, b, h) do { _Pragma("unroll") for (int n = 0; n < 2; ++n) _Pragma("unroll") for (int k = 0; k < 2; ++k) dst[n][k] = *(const LAS bf16x8*)(lds + PG8_SB(b, h) + boff + n * 2048 + k * 1024); } while (0)
#define PG8_MMA(ai, bj, At, Bt) do { __builtin_amdgcn_s_setprio(1); _Pragma("unroll") for (int m = 0; m < 4; ++m) _Pragma("unroll") for (int n = 0; n < 2; ++n) _Pragma("unroll") for (int k = 0; k < 2; ++k) \
        acc[ai][bj][m][n] = __builtin_amdgcn_mfma_f32_16x16x32_bf16(Bt[n][k], At[m][k], acc[ai][bj][m][n], 0, 0, 0); __builtin_amdgcn_s_setprio(0); } while (0)
#define PG8_WAIT_V(n) asm volatile("s_waitcnt vmcnt(" #n ")" ::: "memory")
#define PG8_WAIT_L(n) asm volatile("s_waitcnt lgkmcnt(" #n ")" ::: "memory")
#define PG8_BAR __builtin_amdgcn_s_barrier()
#define PG8_SCHED __builtin_amdgcn_sched_barrier(0)
    Unit cur, nxt; int ui = 0;
    if (!S.next(0, cur)) return;
    f32x4 acc[2][2][4][2];
#pragma unroll
    for (int a = 0; a < 2; ++a)
#pragma unroll
        for (int b = 0; b < 2; ++b)
#pragma unroll
            for (int m = 0; m < 4; ++m)
#pragma unroll
                for (int n = 0; n < 2; ++n) acc[a][b][m][n] = (f32x4){0.f, 0.f, 0.f, 0.f};
    bf16x8 At[4][2], B0[2][2], B1[2][2];
    const char* cA = PG8_BASEA(cur); const char* cB = PG8_BASEB(cur);
    PG8_STAGE(PG8_SB(0, 0), cB, voffB); PG8_STAGE(PG8_SB(0, 1), cB + hstep, voffB); PG8_STAGE(PG8_SA(0, 0), cA, voffA); PG8_STAGE(PG8_SA(0, 1), cA + hstep, voffA);
    if (wr == 1) PG8_BAR;
    PG8_WAIT_V(2); PG8_BAR;
    PG8_STAGE(PG8_SB(1, 0), cB + kstep, voffB); PG8_STAGE(PG8_SA(1, 0), cA + kstep, voffA); PG8_STAGE(PG8_SB(1, 1), cB + hstep + kstep, voffB);
    PG8_WAIT_V(6); PG8_BAR;
    for (;;) {
        const bool has_next = S.next(ui + 1, nxt);
        const char* nA = has_next ? PG8_BASEA(nxt) : cA; const char* nB = has_next ? PG8_BASEB(nxt) : cB;
        const int nt = PG8_NT(cur);
        for (int t = 0; t < nt; t += 2) {
            const bool last = (t == nt - 2);
            const char* a1 = cA + (size_t)(t + 1) * kstep;
            const char* a2 = last ? nA : cA + (size_t)(t + 2) * kstep; const char* b2 = last ? nB : cB + (size_t)(t + 2) * kstep;
            const char* a3 = a2 + kstep; const char* b3 = b2 + kstep;
            PG8_LDB(B0, 0, 0); PG8_LDB(B1, 0, 1); PG8_SCHED; PG8_LDA(At, 0, 0); PG8_STAGE(PG8_SA(1, 1), a1 + hstep, voffA);
            PG8_WAIT_V(8); PG8_WAIT_L(0); PG8_BAR; PG8_MMA(0, 0, At, B0); PG8_MMA(0, 1, At, B1); PG8_BAR; PG8_SCHED;
            PG8_LDA(At, 0, 1); PG8_STAGE(PG8_SB(0, 0), b2, voffB); PG8_STAGE(PG8_SB(0, 1), b2 + hstep, voffB); PG8_STAGE(PG8_SA(0, 0), a2, voffA);
            PG8_WAIT_V(8); PG8_WAIT_L(0); PG8_BAR; PG8_MMA(1, 0, At, B0); PG8_MMA(1, 1, At, B1); PG8_BAR; PG8_SCHED;
            PG8_LDB(B0, 1, 0); PG8_LDB(B1, 1, 1); PG8_SCHED; PG8_LDA(At, 1, 0); PG8_STAGE(PG8_SA(0, 1), a2 + hstep, voffA);
            PG8_WAIT_V(8); PG8_WAIT_L(0); PG8_BAR; PG8_MMA(0, 0, At, B0); PG8_MMA(0, 1, At, B1); PG8_BAR; PG8_SCHED;
            PG8_LDA(At, 1, 1); PG8_STAGE(PG8_SB(1, 0), b3, voffB); PG8_STAGE(PG8_SB(1, 1), b3 + hstep, voffB); PG8_STAGE(PG8_SA(1, 0), a3, voffA);
            PG8_WAIT_V(8); PG8_WAIT_L(0); PG8_BAR; PG8_MMA(1, 0, At, B0); PG8_MMA(1, 1, At, B1); PG8_BAR; PG8_SCHED;
        }
        if (wr == 0) PG8_BAR;
        E(acc, cur, wr, wc, fr, fq);
        if (!has_next) break;
#pragma unroll
        for (int a = 0; a < 2; ++a)
#pragma unroll
            for (int b = 0; b < 2; ++b)
#pragma unroll
                for (int m = 0; m < 4; ++m)
#pragma unroll
                    for (int n = 0; n < 2; ++n) acc[a][b][m][n] = (f32x4){0.f, 0.f, 0.f, 0.f};
        cur = nxt; cA = nA; cB = nB; ++ui;
        if (wr == 1) PG8_BAR;
    }
    PG8_WAIT_V(0);
    PG8_BAR;
#undef PG8_BASEA
#undef PG8_BASEB
#undef PG8_KS
#undef PG8_CT
#undef PG8_NT
#undef PG8_SA
#undef PG8_SB
#undef PG8_STAGE
#undef PG8_LDA
#undef PG8_LDB
#undef PG8_MMA
#undef PG8_WAIT_V
#undef PG8_WAIT_L
#undef PG8_BAR
#undef PG8_SCHED
}
}

constexpr int DM = 1024, NTOK = 8192, NPR = 4096, DFF = 2816, INW = 2560;
constexpr int LDS_BYTES = 147456;
constexpr float EPSF = 1e-6f;
constexpr size_t MiB = 1u << 20;
constexpr size_t WS_WUP = 0;
constexpr size_t WS_W2T = 44 * MiB;
constexpr size_t WS_WIN = 66 * MiB;
constexpr size_t WS_WOUT = 76 * MiB;
constexpr size_t WS_ROPE = 80 * MiB + 524288;
constexpr size_t WS_KF = 81 * MiB;
constexpr size_t WS_CKN = 90 * MiB;
constexpr size_t WS_CVN = WS_CKN + 786432;
constexpr size_t WS_CKG = WS_CVN + 786432;
constexpr size_t WS_CVG = WS_CKG + 262144;
constexpr size_t WS_H = 92 * MiB;
constexpr size_t WS_U = 108 * MiB;
constexpr size_t WS_P = 152 * MiB;
constexpr size_t WS_QN = 152 * MiB, WS_KN = 158 * MiB, WS_VN = 164 * MiB, WS_QG = 170 * MiB, WS_KG = 176 * MiB, WS_VG = 178 * MiB, WS_Z = 180 * MiB, WS_X0 = 188 * MiB;
constexpr size_t WS_Y = 216 * MiB;
constexpr size_t WS_CTL = 232 * MiB, WS_MOD = WS_CTL + 16384, CTL_BYTES = 16384 + 2 * 3 * 9216 * 4;
constexpr size_t WS_KFT = 233 * MiB;
constexpr size_t WS_END = 238 * MiB;

struct Params { const float* in[31]; float* out; unsigned char* ws; };

DI unsigned f2bf(float f) { unsigned u = __float_as_uint(f); return (u + 0x7fffu + ((u >> 16) & 1u)) >> 16; }
DI unsigned pk2(float lo, float hi) { return f2bf(lo) | (f2bf(hi) << 16); }
DI unsigned pk2_fast(float lo, float hi) { return __builtin_amdgcn_perm(__float_as_uint(hi) + 0x8000u, __float_as_uint(lo) + 0x8000u, 0x07060302u); }
DI float bf2f(bf16_t v) { return __uint_as_float(((unsigned)v) << 16); }
DI float wave_sum(float v) {
#pragma unroll
    for (int o = 1; o < 64; o <<= 1) v += __shfl_xor(v, o);
    return v;
}
DI float silu_acc(float a) { return a / (1.0f + expf(-a)); }

DI void transpose_item(const float* W, int N, bf16_t* WT, int K, int k0, int n0, int dst_row0, LAS float* scr, int lane) {
    {
        const int ln4 = lane & 7, rw = lane >> 3;
        f32x4 v[8];
#pragma unroll
        for (int i = 0; i < 8; ++i) v[i] = __builtin_nontemporal_load((const f32x4*)(W + (size_t)(k0 + 8 * i + rw) * N + n0 + 4 * ln4));
#pragma unroll
        for (int i = 0; i < 8; ++i) { LAS float* d = scr + (8 * i + rw) * 33 + 4 * ln4; d[0] = v[i][0]; d[1] = v[i][1]; d[2] = v[i][2]; d[3] = v[i][3]; }
    }
    asm volatile("s_waitcnt lgkmcnt(0)" ::: "memory");
    const int c = lane & 7;
#pragma unroll
    for (int j = 0; j < 4; ++j) { const int n = (lane >> 3) + 8 * j; const LAS float* s = scr + (8 * c) * 33 + n;
        u32x4 o; o.x = pk2(s[0 * 33], s[1 * 33]); o.y = pk2(s[2 * 33], s[3 * 33]); o.z = pk2(s[4 * 33], s[5 * 33]); o.w = pk2(s[6 * 33], s[7 * 33]);
        *(u32x4*)(WT + (size_t)(dst_row0 + n) * K + k0 + 8 * c) = o; }
    asm volatile("s_waitcnt lgkmcnt(0)" ::: "memory");
}

DI void filter_item(const float* w1, const float* b1, const float* w2, const float* b2, const float* w3, const float* fr, int L, int pos, float* KF, int lane) {
    const float tpos = (float)pos / (float)(L - 1);
    float feat = 0.f;
    if (lane == 0) feat = tpos;
    else if (lane <= 32) { const int i = (lane - 1) & 15; const float band = 1e-4f + (15.0f - 1e-4f) * (float)i / 15.0f;
        const float ang = (6.283185307179586f / (float)L) * (float)pos * band; feat = (lane <= 16) ? cosf(ang) : -sinf(ang); }
    float a = b1[lane];
    for (int e = 0; e < 33; ++e) a += __shfl(feat, e) * w1[e * 64 + lane];
    const float hid1 = sinf(fr[lane] * a);
    a = b2[lane];
    for (int j = 0; j < 64; ++j) a += __shfl(hid1, j) * w2[j * 64 + lane];
    const float hid2 = sinf(fr[64 + lane] * a);
    float acc[8];
#pragma unroll
    for (int q = 0; q < 8; ++q) acc[q] = 0.f;
    for (int j = 0; j < 64; ++j) { const float hj = __shfl(hid2, j);
#pragma unroll
        for (int q = 0; q < 8; ++q) acc[q] += hj * w3[j * 512 + q * 64 + lane]; }
    const float min_decay = -3.0701134573253944f, max_decay = -15.350567286626972f;
#pragma unroll
    for (int q = 0; q < 8; ++q) {
        const int c = lane + 64 * (q & 3);
        const float delta = fabsf(min_decay + (max_decay - min_decay) * (float)c / 255.0f);
        const float val = acc[q] * expf(-tpos * delta);
        if (q < 4) KF[(size_t)(L + pos) * 256 + c] = val;
        else if (pos >= 1) KF[(size_t)(L - pos) * 256 + c] = val;
    }
}

DI void combine_norm(const float* xsP, const float* xsS, const bf16_t* Pp, const float* gate, float gfac, float* X,
                     const float* ng, const float* sc, const float* sh, bf16_t* H, int gw, int NGW, int lane) {
    for (int m0 = 4 * gw; m0 < NTOK; m0 += 4 * NGW) {
        const int mi = (m0 < NPR) ? 0 : 1 + ((m0 - NPR) >> 11);
        const float* xr = (m0 < NPR) ? xsP + (size_t)m0 * DM : xsS + (size_t)(m0 - NPR) * DM;
        f32x4 v[4][4]; u32x2 q0[4][4], q1[4][4]; f32x4 gt[4];
#pragma unroll
        for (int r = 0; r < 4; ++r)
#pragma unroll
            for (int j = 0; j < 4; ++j) { const int col = 4 * lane + 256 * j; v[r][j] = *(const f32x4*)(xr + (size_t)r * DM + col);
                if (Pp) { q0[r][j] = *(const u32x2*)(Pp + (size_t)(m0 + r) * DM + col); q1[r][j] = *(const u32x2*)(Pp + (size_t)NTOK * DM + (size_t)(m0 + r) * DM + col); } }
        if (Pp) {
#pragma unroll
            for (int j = 0; j < 4; ++j) gt[j] = *(const f32x4*)(gate + mi * 9216 + 4 * lane + 256 * j) * gfac;
        }
        f32x4 g[4], s1[4], s0[4];
        if (H) {
#pragma unroll
            for (int j = 0; j < 4; ++j) { const int col = 4 * lane + 256 * j; g[j] = *(const f32x4*)(ng + col); s1[j] = *(const f32x4*)(sc + mi * 9216 + col); s0[j] = *(const f32x4*)(sh + mi * 9216 + col); }
        }
        float ss[4];
#pragma unroll
        for (int r = 0; r < 4; ++r) { ss[r] = 0.f;
#pragma unroll
            for (int j = 0; j < 4; ++j) { const int col = 4 * lane + 256 * j;
                if (Pp) { const u32x2 a = q0[r][j], b = q1[r][j];
                    const f32x4 p0 = (f32x4){__uint_as_float(a.x << 16), __uint_as_float(a.x & 0xffff0000u), __uint_as_float(a.y << 16), __uint_as_float(a.y & 0xffff0000u)};
                    const f32x4 p1 = (f32x4){__uint_as_float(b.x << 16), __uint_as_float(b.x & 0xffff0000u), __uint_as_float(b.y << 16), __uint_as_float(b.y & 0xffff0000u)};
                    v[r][j] += gt[j] * (p0 + p1); }
                *(f32x4*)(X + (size_t)(m0 + r) * DM + col) = v[r][j];
                ss[r] += (v[r][j][0] * v[r][j][0] + v[r][j][1] * v[r][j][1]) + (v[r][j][2] * v[r][j][2] + v[r][j][3] * v[r][j][3]); } }
        if (H) {
#pragma unroll
            for (int o = 1; o < 64; o <<= 1) {
#pragma unroll
                for (int r = 0; r < 4; ++r) ss[r] += __shfl_xor(ss[r], o); }
#pragma unroll
            for (int r = 0; r < 4; ++r) { const float rr = rsqrtf(ss[r] * (1.0f / DM) + EPSF);
#pragma unroll
                for (int j = 0; j < 4; ++j) { const int col = 4 * lane + 256 * j;
                    const f32x4 h = (v[r][j] * rr) * g[j] * (1.0f + s1[j]) + s0[j];
                    u32x2 w; w.x = pk2(h[0], h[1]); w.y = pk2(h[2], h[3]);
                    *(u32x2*)(H + (size_t)(m0 + r) * DM + col) = w; } }
        }
    }
}

#define MFMA16(a, b, c) __builtin_amdgcn_mfma_f32_16x16x32_bf16((a), (b), (c), 0, 0, 0)
DI void fa_load(bf16x8 (&kf)[4], bf16x8 (&vf)[4], const bf16_t* Kt, int kst, const bf16_t* Vt, int fr, int fq) {
    const bf16_t* kr0 = Kt + (size_t)(8 * (fr >> 2) + (fr & 3)) * kst + 16 * fq;
    const bf16_t* kr1 = kr0 + (size_t)4 * kst;
    kf[0] = *(const bf16x8*)kr0; kf[1] = *(const bf16x8*)(kr0 + 8); kf[2] = *(const bf16x8*)kr1; kf[3] = *(const bf16x8*)(kr1 + 8);
#pragma unroll
    for (int db = 0; db < 4; ++db) vf[db] = *(const bf16x8*)(Vt + fq * 512 + (16 * db + fr) * 8);
}
DI void fa_scores(float* sv, const bf16x8 (&kf)[4], const bf16x8 (&qf)[2]) {
    f32x4 s0 = (f32x4){0.f, 0.f, 0.f, 0.f}, s1 = (f32x4){0.f, 0.f, 0.f, 0.f};
    s0 = MFMA16(kf[0], qf[0], s0); s1 = MFMA16(kf[2], qf[0], s1); s0 = MFMA16(kf[1], qf[1], s0); s1 = MFMA16(kf[3], qf[1], s1);
    sv[0] = s0[0]; sv[1] = s0[1]; sv[2] = s0[2]; sv[3] = s0[3]; sv[4] = s1[0]; sv[5] = s1[1]; sv[6] = s1[2]; sv[7] = s1[3];
}
template <int NQ, int NBUF>
DI void attn_item(const bf16_t* const (&Qrow)[NQ], bf16_t* const (&Yrow)[NQ], const float (&m0)[NQ], float l0,
                  const bf16_t* Kl, const bf16_t* Vl, int tok0, int tstep, int nloc,
                  const bf16_t* Kc, const bf16_t* Vc, int nctx, int kst, int mode,
                  const LAS float* rp, int drow0, int col0, int qc, int wlo, int kpos0, int qpos, int fr, int fq) {
    bf16x8 qf[NQ][2]; f32x4 o[NQ][4]; float m[NQ], l[NQ];
#pragma unroll
    for (int q = 0; q < NQ; ++q) { qf[q][0] = *(const bf16x8*)(Qrow[q] + 16 * fq); qf[q][1] = *(const bf16x8*)(Qrow[q] + 16 * fq + 8);
#pragma unroll
        for (int db = 0; db < 4; ++db) o[q][db] = (f32x4){0.f, 0.f, 0.f, 0.f};
        m[q] = m0[q]; l[q] = (fq == 0) ? l0 : 0.f; }
    const int nst = nloc + nctx;
    const int p0u = __builtin_amdgcn_readfirstlane(qpos - fr);
    bf16x8 kb[NBUF][4], vb[NBUF][4];
#define FA_LOAD_TILE(T, B) do { const bf16_t* Kp_; const bf16_t* Vp_; \
        if ((T) < nloc) { const int tok_ = tok0 + (T) * tstep; Kp_ = Kl + (size_t)tok_ * kst; Vp_ = Vl + (size_t)(tok_ >> 3) * 512; } \
        else { const int i_ = (T) - nloc; Kp_ = Kc + (size_t)(32 * i_) * kst; Vp_ = Vc + (size_t)i_ * 2048; } \
        fa_load(kb[B], vb[B], Kp_, kst, Vp_, fr, fq); } while (0)
#pragma unroll
    for (int b = 0; b < NBUF; ++b) if (b < nst) FA_LOAD_TILE(b, b);
    for (int s0 = 0; s0 < nst; s0 += NBUF) {
#pragma unroll
        for (int b = 0; b < NBUF; ++b) {
            const int st = s0 + b;
            if (st < nst) {
#pragma unroll
                for (int q = 0; q < NQ; ++q) {
                    float sv[8];
                    fa_scores(sv, kb[b], qf[q]);
                    if (st < nloc) {
                        if (mode == 1) {
                            const LAS float* rpr = rp + (drow0 + st) * 31;
#pragma unroll
                            for (int jj = 0; jj < 8; ++jj) { const int kcol = col0 + 8 * fq + jj; const bool ok = (kcol >= wlo) && (kcol < wlo + 16);
                                const int dc = min(max(kcol - qc, -15), 15);
                                sv[jj] = ok ? sv[jj] + rpr[dc + 15] : -INFINITY; }
                        } else if (mode == 2 && (kpos0 + 32 * st + 31 - p0u > 128 || kpos0 + 32 * st - (p0u + 15) < -128)) {
#pragma unroll
                            for (int jj = 0; jj < 8; ++jj) { const int dd = kpos0 + 32 * st + 8 * fq + jj - qpos; if (dd > 128 || dd < -128) sv[jj] = -INFINITY; }
                        }
                    }
                    float mx = fmaxf(fmaxf(fmaxf(sv[0], sv[1]), fmaxf(sv[2], sv[3])), fmaxf(fmaxf(sv[4], sv[5]), fmaxf(sv[6], sv[7])));
                    mx = fmaxf(mx, __shfl_xor(mx, 16)); mx = fmaxf(mx, __shfl_xor(mx, 32));
                    const float mn = fmaxf(m[q], mx), alpha = __expf(m[q] - mn);
                    float rs = 0.f;
#pragma unroll
                    for (int j = 0; j < 8; ++j) { sv[j] = __expf(sv[j] - mn); rs += sv[j]; }
                    l[q] = l[q] * alpha + rs; m[q] = mn;
                    u32x4 pw; pw.x = pk2_fast(sv[0], sv[1]); pw.y = pk2_fast(sv[2], sv[3]); pw.z = pk2_fast(sv[4], sv[5]); pw.w = pk2_fast(sv[6], sv[7]);
                    const bf16x8 pf = __builtin_bit_cast(bf16x8, pw);
#pragma unroll
                    for (int db = 0; db < 4; ++db) { o[q][db] = o[q][db] * alpha; o[q][db] = MFMA16(vb[b][db], pf, o[q][db]); }
                }
                if (st + NBUF < nst) FA_LOAD_TILE(st + NBUF, b);
            }
        }
    }
#undef FA_LOAD_TILE
#pragma unroll
    for (int q = 0; q < NQ; ++q) {
        float lq = l[q]; lq += __shfl_xor(lq, 16); lq += __shfl_xor(lq, 32);
        const float inv = 1.0f / lq;
#pragma unroll
        for (int db = 0; db < 4; ++db) { u32x2 w; w.x = pk2(o[q][db][0] * inv, o[q][db][1] * inv); w.y = pk2(o[q][db][2] * inv, o[q][db][3] * inv);
            *(u32x2*)(Yrow[q] + 16 * db + 4 * fq) = w; }
    }
}

DI void hyena_block(LAS unsigned char* lds, int tid, int c, int L, bool sample, const bf16_t* KFTx  , const bf16_t* ZT, const bf16_t* X0T, bf16_t* YT, float sk) {
    const int lane = tid & 63, wave = __builtin_amdgcn_readfirstlane(tid >> 6), fr = lane & 15, fq = lane >> 4;
    const int CP = (2 * L + 16) * 2, ZL = 3 * L;
    constexpr int ZOFF = 8 * 8224;
    __syncthreads();
    {
        const bf16_t* kft = KFTx + (size_t)c * 2 * L;
        const bool has_t = 8 * tid < 2 * L;
        u32x4 tv = (u32x4){0u, 0u, 0u, 0u};
        if (has_t) tv = *(const u32x4*)(kft + 8 * tid);
        const int tpb = L >> 3, zb = tid / tpb, zs0 = 8 * (tid - zb * tpb);
        const int zm0 = sample ? NPR + zb * 2048 : zb * 256;
        const u32x4 zv = *(const u32x4*)(ZT + (size_t)zm0 * 256 + (size_t)c * L + zs0);
#pragma unroll
        for (int k = 0; k < 2; ++k) { const int e0 = 8 * (tid + 512 * k), pb = e0 / (2 * L), off = e0 - pb * 2 * L, pos = off < L ? off : off + L;
            *(LAS u32x4*)(lds + ZOFF + 2 * (pb * ZL + pos)) = (u32x4){0u, 0u, 0u, 0u}; }
        *(LAS u32x4*)(lds + ZOFF + 2 * (zb * ZL + L + zs0)) = zv;
        if (has_t) {
            const unsigned tw[4] = {tv.x, tv.y, tv.z, tv.w};
#pragma unroll
            for (int k = 0; k < 8; ++k) { const int ee = 8 * tid + k; const unsigned short v = (unsigned short)((k & 1) ? (tw[k >> 1] >> 16) : (tw[k >> 1] & 0xffffu));
                if (ee >= 1) { const int x = 2 * L - ee;
#pragma unroll
                    for (int r = 0; r < 8; ++r) *(LAS unsigned short*)(lds + r * CP + 2 * (x + r)) = v; } }
        }
    }
    __syncthreads();
    const int nb = L >> 5;
    const int Ibase = sample ? 8 * wave : 0, bbase = sample ? 0 : 2 * wave;
    const int I = Ibase + (fr & 7), b = bbase + (fr >> 3);
    const int Dlo = max(Ibase - (nb - 1), -(nb - 1)), Dhi = min(Ibase + 7, nb - 1);
    f32x4 acc0 = (f32x4){0.f, 0.f, 0.f, 0.f}, acc1 = acc0;
    const int abase = (fr & 7) * CP + 2 * (L - 8 * (fr >> 3) + 8 * fq);
    const int bbyte = ZOFF + 2 * (b * ZL + L + 32 * I + 8 * fq);
#pragma unroll 4
    for (int D = Dlo; D <= Dhi; ++D) {
        const bf16x8 a0 = *(const LAS bf16x8*)(lds + abase - 64 * D);
        const bf16x8 a1 = *(const LAS bf16x8*)(lds + abase - 64 * D - 32);
        const bf16x8 bfr = *(const LAS bf16x8*)(lds + bbyte - 64 * D);
        acc0 = MFMA16(a0, bfr, acc0); acc1 = MFMA16(a1, bfr, acc1);
    }
    const int mb = sample ? NPR + b * 2048 : b * 256;
#pragma unroll
    for (int ib = 0; ib < 2; ++ib) {
        const int t = 32 * I + 16 * ib + 4 * fq;
        const u32x2 zz = *(const LAS u32x2*)(lds + ZOFF + 2 * (b * ZL + L + t));
        const u32x2 xx = *(const u32x2*)(X0T + (size_t)mb * 256 + (size_t)c * L + t);
        const float zf[4] = {__uint_as_float(zz.x << 16), __uint_as_float(zz.x & 0xffff0000u), __uint_as_float(zz.y << 16), __uint_as_float(zz.y & 0xffff0000u)};
        const float xf[4] = {__uint_as_float(xx.x << 16), __uint_as_float(xx.x & 0xffff0000u), __uint_as_float(xx.y << 16), __uint_as_float(xx.y & 0xffff0000u)};
        float y[4];
#pragma unroll
        for (int i = 0; i < 4; ++i) { const float a = ib ? acc1[i] : acc0[i]; y[i] = (a + zf[i] * sk) * xf[i]; }
        u32x2 w; w.x = pk2(y[0], y[1]); w.y = pk2(y[2], y[3]);
        *(u32x2*)(YT + (size_t)c * NTOK + mb + t) = w;
    }
}

#define XB_TMO      128
#define XB_XCNT(j)  (256  + 64 * (j))
#define XB_XSUB(j)  (1280 + 64 * (j))
#define XB_XGEN(j)  (2304 + 64 * (j))
#define XB_TOP      3328
#define XB_TOPGEN   3392
#define XCD_BAR_WORDS 3456
#define XB_SPIN_CAP (1u << 22)
DI unsigned xb_ld(unsigned* p)              { return __hip_atomic_load(p, __ATOMIC_RELAXED, __HIP_MEMORY_SCOPE_AGENT); }
DI unsigned xb_add(unsigned* p, unsigned v) { return __hip_atomic_fetch_add(p, v, __ATOMIC_RELAXED, __HIP_MEMORY_SCOPE_AGENT); }
DI unsigned xb_xcc_id() { return (unsigned)__builtin_amdgcn_s_getreg((3 << 11) | 20) & 0xFu; }
#define XB_SPIN(cond, bar) do { unsigned _sp = 0; while (cond) { __builtin_amdgcn_s_sleep(1); \
    if ((++_sp & 255u) == 0u) { if (xb_ld(&(bar)[XB_TMO])) break; if (_sp > XB_SPIN_CAP) { atomicAdd(&(bar)[XB_TMO], 1u); break; } } } } while (0)
struct XcdBarrier { unsigned* bar; unsigned x; volatile LAS unsigned* st; };
DI XcdBarrier xcd_barrier_post(unsigned* bar, volatile LAS unsigned* st) {
    XcdBarrier b; b.bar = bar; b.x = xb_xcc_id(); b.st = st;
    if (threadIdx.x == 0) (void)xb_add(&bar[XB_XCNT(b.x)], 1u);
    return b;
}
DI void xcd_barrier_complete(unsigned* bar, unsigned x, unsigned& nloc, unsigned& nx) {
    const unsigned G = gridDim.x * gridDim.y * gridDim.z;
    unsigned sum, cnt, mine, sp = 0u;
    for (;;) {
        sum = 0u; cnt = 0u; mine = 0u;
#pragma unroll
        for (unsigned j = 0; j < 16; ++j) { const unsigned c = xb_ld(&bar[XB_XCNT(j)]); sum += c; cnt += (c > 0u) ? 1u : 0u; mine = (j == x) ? c : mine; }
        if (sum == G) break;
        __builtin_amdgcn_s_sleep(1);
        if ((++sp & 255u) == 0u) { if (xb_ld(&bar[XB_TMO])) break; if (sp > XB_SPIN_CAP) { atomicAdd(&bar[XB_TMO], 1u); break; } }
    }
    nloc = mine > 0u ? mine : 1u; nx = cnt > 0u ? cnt : 1u;
}
DI void xcd_barrier(const XcdBarrier& b, const bool leader) {
    asm volatile("s_waitcnt vmcnt(0)" ::: "memory");
    __syncthreads();
    if (leader) {
        unsigned* bar = b.bar;
        __builtin_amdgcn_s_waitcnt(0);
        unsigned nloc = b.st[0], nx = b.st[1];
        if (nloc == 0u) { xcd_barrier_complete(bar, b.x, nloc, nx); b.st[0] = nloc; b.st[1] = nx; }
        const unsigned old = xb_add(&bar[XB_XSUB(b.x)], 1u);
        const unsigned gen = old / nloc;
        if (old + 1u == (gen + 1u) * nloc) {
            __builtin_amdgcn_fence(__ATOMIC_RELEASE, "agent");
            asm volatile("s_waitcnt vmcnt(0)" ::: "memory");
            const unsigned og = xb_add(&bar[XB_TOP], 1u);
            const unsigned tg = og / nx;
            if (og + 1u == (tg + 1u) * nx) xb_add(&bar[XB_TOPGEN], 1u);
            else XB_SPIN(xb_ld(&bar[XB_TOPGEN]) == tg, bar);
            __builtin_amdgcn_fence(__ATOMIC_ACQUIRE, "agent");
            xb_add(&bar[XB_XGEN(b.x)], 1u);
            asm volatile("s_waitcnt vmcnt(0)" ::: "memory");
        } else {
            XB_SPIN(xb_ld(&bar[XB_XGEN(b.x)]) == gen, bar);
            __builtin_amdgcn_fence(__ATOMIC_ACQUIRE, "agent");
            asm volatile("s_waitcnt vmcnt(0)" ::: "memory");
        }
    }
    __syncthreads();
}
constexpr int MISC_OFF = 131072 + 320;

typedef const __attribute__((address_space(4))) Params* KP;
#define PH_BEGIN \
    KP kp = (KP)__builtin_amdgcn_kernarg_segment_ptr(); asm volatile("" : "+s"(kp)); \
    unsigned lz_ = 0u; asm volatile("" : "+v"(lz_));     \
    int tid = wv * 64 + (int)__builtin_amdgcn_mbcnt_hi(~0u, __builtin_amdgcn_mbcnt_lo(~0u, lz_)); \
    const int lane = tid & 63, wave = __builtin_amdgcn_readfirstlane(tid >> 6), bid = blockIdx.x, NB = gridDim.x; \
    const int gw = bid * 8 + wave, NGW = NB * 8; \
    unsigned char* ws = kp->ws; (void)lane; (void)gw; (void)NGW; (void)ws;

DI void convert_item(KP kp, unsigned char* ws, int it, LAS float* scr, int lane) {
    const int l = it / 10240; const int r = it % 10240;
    if (r < 8448) { const int j = r / 1408, r2 = r % 1408;
        if (j < 4) { const int f = j & 1, w3 = j >> 1;
            const float* W = (w3 ? kp->in[12] : kp->in[11]) + (size_t)(l * 2 + f) * 1024 * 2816;
            const int kb = r2 / 88, nb = r2 % 88, n0 = 32 * nb;
            transpose_item(W, 2816, (bf16_t*)(ws + WS_WUP) + (size_t)(l * 2 + f) * 5632 * 1024, 1024, 64 * kb, n0, 256 * (n0 >> 7) + 128 * w3 + (n0 & 127), scr, lane);
        } else { const int f = j - 4; const float* W = kp->in[13] + (size_t)(l * 2 + f) * 2816 * 1024;
            const int kb = r2 / 32, nb = r2 % 32;
            transpose_item(W, 1024, (bf16_t*)(ws + WS_W2T) + (size_t)(l * 2 + f) * 1024 * 2816, 2816, 64 * kb, 32 * nb, 32 * nb, scr, lane); }
    } else if (r < 9728) { const int r2 = r - 8448, kb = r2 / 80, nb = r2 % 80;
        transpose_item(kp->in[14] + (size_t)l * 1024 * 2560, 2560, (bf16_t*)(ws + WS_WIN) + (size_t)l * 2560 * 1024, 1024, 64 * kb, 32 * nb, 32 * nb, scr, lane);
    } else { const int r2 = r - 9728, kb = r2 / 32, nb = r2 % 32;
        transpose_item(kp->in[15] + (size_t)l * 1024 * 1024, 1024, (bf16_t*)(ws + WS_WOUT) + (size_t)l * 1024 * 1024, 1024, 64 * kb, 32 * nb, 32 * nb, scr, lane); }
}
struct TrItem { const float* W; bf16_t* WT; int N, K, k0, n0, dst_row0; };
DI TrItem decode_item(KP kp, unsigned char* ws, int it) {
    TrItem t; const int l = it / 10240; const int r = it % 10240;
    if (r < 8448) { const int j = r / 1408, r2 = r % 1408;
        if (j < 4) { const int f = j & 1, w3 = j >> 1; const int kb = r2 / 88, nb = r2 % 88, n0 = 32 * nb;
            t.W = (w3 ? kp->in[12] : kp->in[11]) + (size_t)(l * 2 + f) * 1024 * 2816; t.N = 2816; t.WT = (bf16_t*)(ws + WS_WUP) + (size_t)(l * 2 + f) * 5632 * 1024; t.K = 1024;
            t.k0 = 64 * kb; t.n0 = n0; t.dst_row0 = 256 * (n0 >> 7) + 128 * w3 + (n0 & 127);
        } else { const int f = j - 4, kb = r2 / 32, nb = r2 % 32;
            t.W = kp->in[13] + (size_t)(l * 2 + f) * 2816 * 1024; t.N = 1024; t.WT = (bf16_t*)(ws + WS_W2T) + (size_t)(l * 2 + f) * 1024 * 2816; t.K = 2816; t.k0 = 64 * kb; t.n0 = 32 * nb; t.dst_row0 = 32 * nb; }
    } else if (r < 9728) { const int r2 = r - 8448, kb = r2 / 80, nb = r2 % 80;
        t.W = kp->in[14] + (size_t)l * 1024 * 2560; t.N = 2560; t.WT = (bf16_t*)(ws + WS_WIN) + (size_t)l * 2560 * 1024; t.K = 1024; t.k0 = 64 * kb; t.n0 = 32 * nb; t.dst_row0 = 32 * nb;
    } else { const int r2 = r - 9728, kb = r2 / 32, nb = r2 % 32;
        t.W = kp->in[15] + (size_t)l * 1024 * 1024; t.N = 1024; t.WT = (bf16_t*)(ws + WS_WOUT) + (size_t)l * 1024 * 1024; t.K = 1024; t.k0 = 64 * kb; t.n0 = 32 * nb; t.dst_row0 = 32 * nb; }
    return t;
}
DI void tr_load(f32x4 (&v)[8], const TrItem& t, int lane) {
    const int ln4 = lane & 7, rw = lane >> 3;
#pragma unroll
    for (int i = 0; i < 8; ++i) v[i] = __builtin_nontemporal_load((const f32x4*)(t.W + (size_t)(t.k0 + 8 * i + rw) * t.N + t.n0 + 4 * ln4));
}
DI void tr_store(const f32x4 (&v)[8], const TrItem& t, LAS float* scr, int lane) {
    const int ln4 = lane & 7, rw = lane >> 3;
#pragma unroll
    for (int i = 0; i < 8; ++i) { LAS float* d = scr + (8 * i + rw) * 33 + 4 * ln4; d[0] = v[i][0]; d[1] = v[i][1]; d[2] = v[i][2]; d[3] = v[i][3]; }
    asm volatile("s_waitcnt lgkmcnt(0)" ::: "memory");
    const int c = lane & 7;
#pragma unroll
    for (int j = 0; j < 4; ++j) { const int n = (lane >> 3) + 8 * j; const LAS float* s = scr + (8 * c) * 33 + n;
        u32x4 o; o.x = pk2(s[0 * 33], s[1 * 33]); o.y = pk2(s[2 * 33], s[3 * 33]); o.z = pk2(s[4 * 33], s[5 * 33]); o.w = pk2(s[6 * 33], s[7 * 33]);
        *(u32x4*)(t.WT + (size_t)(t.dst_row0 + n) * t.K + t.k0 + 8 * c) = o; }
    asm volatile("s_waitcnt lgkmcnt(0)" ::: "memory");
}
DI void convert_segs(KP kp, unsigned char* ws, LAS unsigned char* lds, int wave, int lane, int widx, int nw, int s0, int c0, int s1, int c1, int s2, int c2) {
    LAS float* scr = (LAS float*)(lds + wave * 16384);
    const int total = c0 + c1 + c2;
#define SEG_ITEM(q) ((q) < c0 ? s0 + (q) : ((q) < c0 + c1 ? s1 + ((q) - c0) : s2 + ((q) - c0 - c1)))
    int q = widx;
    if (q < total) {
        TrItem cur = decode_item(kp, ws, SEG_ITEM(q)); f32x4 v[8]; tr_load(v, cur, lane);
        for (;;) {
            const int qn = q + nw; const bool more = qn < total;
            TrItem nxt = cur; f32x4 vn[8];
            if (more) { nxt = decode_item(kp, ws, SEG_ITEM(qn)); tr_load(vn, nxt, lane); }
            tr_store(v, cur, scr, lane);
            if (!more) break;
#pragma unroll
            for (int i = 0; i < 8; ++i) v[i] = vn[i];
            cur = nxt; q = qn;
        }
    }
#undef SEG_ITEM
}

DI void phase0(LAS unsigned char* lds, int wv) {
    PH_BEGIN
    const int gtid = bid * 512 + tid, NGT = NB * 512;
    float* MOD = (float*)(ws + WS_MOD);
    {
        const float* cctx = kp->in[7]; const float* cs = kp->in[6]; const float* ab = kp->in[9];
        LAS float* sl = (LAS float*)(lds + 131072 + 1024);
        for (int i = tid; i < 3072; i += 512) sl[i] = silu_acc(i < 1024 ? cctx[i] : cs[i - 1024]);
        __syncthreads();
        LAS float* red = (LAS float*)lds;
        for (int it = gw; it < 2304; it += NGW) {
            const int itb = it - wave, l = itb / 1152, r = itb % 1152, cgp = r >> 5, kc = (r & 31) + wave, col = 256 * cgp + 4 * lane;
            const float* aw = kp->in[8] + (size_t)l * 1024 * 9216 + (size_t)(32 * kc) * 9216 + col;
            f32x4 a0 = (f32x4){0.f, 0.f, 0.f, 0.f}, a1 = a0, a2 = a0;
#pragma unroll
            for (int k = 0; k < 32; ++k) {
                const f32x4 wv = __builtin_nontemporal_load((const f32x4*)(aw + (size_t)k * 9216));
                const float s0 = sl[32 * kc + k], s1 = sl[1024 + 32 * kc + k], s2 = sl[2048 + 32 * kc + k];
                a0 += s0 * wv; a1 += s1 * wv; a2 += s2 * wv;
            }
            *(LAS f32x4*)(red + (wave * 3 + 0) * 256 + 4 * lane) = a0; *(LAS f32x4*)(red + (wave * 3 + 1) * 256 + 4 * lane) = a1; *(LAS f32x4*)(red + (wave * 3 + 2) * 256 + 4 * lane) = a2;
            __syncthreads();
            for (int o = tid; o < 768; o += 512) { const int mi = o >> 8, cc = o & 255;
                float sacc = ((r & 31) == 0) ? ab[l * 9216 + 256 * cgp + cc] : 0.f;
#pragma unroll
                for (int w = 0; w < 8; ++w) sacc += red[(w * 3 + mi) * 256 + cc];
                unsafeAtomicAdd(MOD + (size_t)(l * 3 + mi) * 9216 + 256 * cgp + cc, sacc); }
            __syncthreads();
        }
    }
    LAS float* scr = (LAS float*)(lds + wave * 16384);
    if (NB == 256) convert_segs(kp, ws, lds, wave, lane, (gw + NGW - 256) % NGW, NGW, 0, 1408, 2816, 1408, 0, 0);
    else convert_segs(kp, ws, lds, wave, lane, gw, NGW, 0, 20480, 0, 0, 0, 0);
    for (int it = (NB == 256) ? (gw + NGW - 1024) % NGW : gw; it < 4608; it += NGW) {
        const int l = it / 2304, r = it % 2304;
        float* KFl = (float*)(ws + WS_KF) + (size_t)l * 1179648;
        const float* w1 = kp->in[18] + (size_t)l * 33 * 64; const float* b1 = kp->in[19] + l * 64;
        const float* w2 = kp->in[20] + (size_t)l * 64 * 64; const float* b2 = kp->in[21] + l * 64;
        const float* w3 = kp->in[22] + (size_t)l * 64 * 512; const float* frq = kp->in[23] + l * 128;
        if (r < 256) filter_item(w1, b1, w2, b2, w3, frq, 256, r, KFl, lane);
        else filter_item(w1, b1, w2, b2, w3, frq, 2048, r - 256, KFl + 131072, lane);
    }
    {
        bf16_t* CKN = (bf16_t*)(ws + WS_CKN); bf16_t* CVN = (bf16_t*)(ws + WS_CVN); bf16_t* CKG = (bf16_t*)(ws + WS_CKG); bf16_t* CVG = (bf16_t*)(ws + WS_CVG);
        const float* cnk = kp->in[2]; const float* cnv = kp->in[3]; const float* cgk = kp->in[4]; const float* cgv = kp->in[5];
        for (int i = gtid; i < 393216; i += NGT) {
            CKN[i] = (bf16_t)f2bf(cnk[i]);
            const int kk = i & 7, d = (i >> 3) & 63, kg = (i >> 9) & 31, key = 8 * kg + kk, h = (i >> 14) % 6, bl = i / 98304;
            CVN[i] = (bf16_t)f2bf(cnv[((size_t)(bl * 256 + key) * 6 + h) * 64 + d]);
        }
        float* ROPE = (float*)(ws + WS_ROPE);
        for (int i = gtid; i < 65536; i += NGT) { const int t = i >> 5, k = i & 31;
            const float ang = (float)(k < 16 ? (t >> 6) : (t & 63)) * expf(-(float)(k & 15) * (9.210340371976184f / 16.0f));
            ROPE[2 * i] = cosf(ang); ROPE[2 * i + 1] = sinf(ang); }
        for (int i = gtid; i < 131072; i += NGT) {
            CKG[i] = (bf16_t)f2bf(cgk[i]);
            const int kk = i & 7, d = (i >> 3) & 63, kg = (i >> 9) & 31, key = 8 * kg + kk, h = (i >> 14) & 1, bl = i >> 15;
            CVG[i] = (bf16_t)f2bf(cgv[((size_t)(bl * 256 + key) * 2 + h) * 64 + d]);
        }
    }
}

DI void ph_combine(LAS unsigned char* lds, int l, int s, bool fin, int wv) {
    PH_BEGIN
    float* MOD = (float*)(ws + WS_MOD); float* X = kp->out; const bf16_t* Pb = (const bf16_t*)(ws + WS_P); bf16_t* Hb = (bf16_t*)(ws + WS_H);
    if (fin) { combine_norm(X, X + (size_t)NPR * DM, Pb, MOD + (size_t)3 * 9216 + 8 * 1024, 0.5f, X, nullptr, nullptr, nullptr, nullptr, gw, NGW, lane); return; }
    const float* MODl = MOD + (size_t)l * 3 * 9216;
    const bool first = (l == 0 && s == 0);
    const float* gate = first ? nullptr : (s == 0 ? MOD + (size_t)(l - 1) * 3 * 9216 + 8 * 1024 : MODl + (s == 1 ? 2 : 5) * 1024);
    const float gfac = (s == 2) ? 1.0f : 0.5f;
    combine_norm(first ? kp->in[0] : X, first ? kp->in[1] : X + (size_t)NPR * DM, first ? nullptr : Pb, gate, gfac, X,
                 kp->in[10] + (size_t)(l * 3 + s) * 1024, MODl + (3 * s + 1) * 1024, MODl + (3 * s) * 1024, Hb, gw, NGW, lane);
    if (l == 1 && s == 0 && NB == 256) convert_segs(kp, ws, lds, wave, lane, gw, NGW, 10240 + 2816 + 256, 1152, 0, 0, 0, 0);
    if (first) {
        LAS float* scr = (LAS float*)(lds + wave * 16384);
        for (int it = gw; it < 1152; it += NGW) { const int ll = it / 576, r = it % 576;
            const float* KFl = (const float*)(ws + WS_KF) + (size_t)ll * 1179648; bf16_t* KFTl = (bf16_t*)(ws + WS_KFT) + (size_t)ll * 1179648;
            if (r < 64) transpose_item(KFl, 256, KFTl, 512, 64 * (r >> 3), 32 * (r & 7), 32 * (r & 7), scr, lane);
            else { const int r2 = r - 64; transpose_item(KFl + 131072, 256, KFTl + 131072, 4096, 64 * (r2 >> 3), 32 * (r2 & 7), 32 * (r2 & 7), scr, lane); } }
    }
}

DI void ph_up(LAS unsigned char* lds, int l, int f, int wv) {
    PH_BEGIN
    pg8::Gemm g{(const bf16_t*)(ws + WS_H), (const bf16_t*)(ws + WS_WUP) + (size_t)(l * 2 + f) * 5632 * 1024, 1024, 1024, 22, 0};
    pg8::StaticOrder S; S.init(NTOK, 5632, NB, bid);
    pg8::EpiUp E{(bf16_t*)(ws + WS_U), DFF};
    pg8::gemm_phase<pg8::EpiUp, pg8::StaticOrder>(lds, g, S, E, tid);
    if (NB == 256 && bid >= 192) {
        const int w = (bid - 192) * 8 + wave, L = 10240 * l;
        if (f == 0) convert_segs(kp, ws, lds, wave, lane, w, 512, L + 5632, 1408, L + 8448, 1280, 0, 0);
        else if (l == 0) convert_segs(kp, ws, lds, wave, lane, w, 512, 7040, 1408, 10240, 1408, 10240 + 2816, 256);
        else convert_segs(kp, ws, lds, wave, lane, w, 512, L + 7040, 1408, 0, 0, 0, 0);
    }
}
DI void ph_part(LAS unsigned char* lds, int l, int f, bool is_out, int wv) {
    PH_BEGIN
    pg8::Gemm g;
    if (is_out) g = pg8::Gemm{(const bf16_t*)(ws + WS_Y), (const bf16_t*)(ws + WS_WOUT) + (size_t)l * 1024 * 1024, 1024, 512, 4, 0};
    else g = pg8::Gemm{(const bf16_t*)(ws + WS_U), (const bf16_t*)(ws + WS_W2T) + (size_t)(l * 2 + f) * 1024 * 2816, 2816, 1408, 4, 0};
    pg8::StaticOrder S; S.init(NTOK, 2048, NB, bid);
    pg8::EpiPart E{(bf16_t*)(ws + WS_P), DM, 4, (size_t)NTOK * DM};
    pg8::gemm_phase<pg8::EpiPart, pg8::StaticOrder>(lds, g, S, E, tid);
}
DI void ph_in(LAS unsigned char* lds, int l, int wv) {
    PH_BEGIN
    pg8::Gemm g{(const bf16_t*)(ws + WS_H), (const bf16_t*)(ws + WS_WIN) + (size_t)l * 2560 * 1024, 1024, 512, 10, 1};
    pg8::InOrder S{NB, bid};
    pg8::EpiInHyb E{(bf16_t*)(ws + WS_U), (bf16_t*)(ws + WS_Y)};
    pg8::gemm_phase<pg8::EpiInHyb, pg8::InOrder>(lds, g, S, E, tid);
    if (NB == 256 && bid >= 128) { const int L = 10240 * l;
        convert_segs(kp, ws, lds, wave, lane, (bid - 128) * 8 + wave, 1024, L + 9728, 512, L + 1408, 1408, L + 4224, 1408); }
}

DI void unpack8(float (&f)[8], const u32x4 w) {
    f[0] = __uint_as_float(w.x << 16); f[1] = __uint_as_float(w.x & 0xffff0000u); f[2] = __uint_as_float(w.y << 16); f[3] = __uint_as_float(w.y & 0xffff0000u);
    f[4] = __uint_as_float(w.z << 16); f[5] = __uint_as_float(w.z & 0xffff0000u); f[6] = __uint_as_float(w.w << 16); f[7] = __uint_as_float(w.w & 0xffff0000u);
}
DI u32x4 pack8(const float (&f)[8]) { u32x4 w; w.x = pk2(f[0], f[1]); w.y = pk2(f[2], f[3]); w.z = pk2(f[4], f[5]); w.w = pk2(f[6], f[7]); return w; }
DI void ph_post(int l, int wv) {
    PH_BEGIN
    const bf16_t* Ub = (const bf16_t*)(ws + WS_U); const bf16_t* P2 = (const bf16_t*)(ws + WS_Y);
    bf16_t* QN = (bf16_t*)(ws + WS_QN); bf16_t* KN = (bf16_t*)(ws + WS_KN); bf16_t* VN = (bf16_t*)(ws + WS_VN);
    bf16_t* QG = (bf16_t*)(ws + WS_QG); bf16_t* KG = (bf16_t*)(ws + WS_KG); bf16_t* VG = (bf16_t*)(ws + WS_VG);
    bf16_t* ZT = (bf16_t*)(ws + WS_Z); bf16_t* X0T = (bf16_t*)(ws + WS_X0);
    const float* ROPE = (const float*)(ws + WS_ROPE);
    float* out_nak = kp->out + 8388608; float* out_nav = out_nak + 3145728; float* out_gk = out_nav + 3145728; float* out_gv = out_gk + 1048576;
    const float* naqg = kp->in[25] + l * 64; const float* nakg = kp->in[26] + l * 64; const float* gqg = kp->in[28] + l * 64; const float* gkg = kp->in[29] + l * 64;
    const float* cw = kp->in[16] + (size_t)l * 3 * 768; const float* cb = kp->in[17] + (size_t)l * 768;
    {
        const int s8 = lane & 7, hl = lane >> 3;
        auto proc = [&](const int m, const int hf, const u32x4 (&raw)[2], const u32x4 (&raw2)[2]) {
            const bool isS = m >= NPR; const int t = isS ? ((m - NPR) & 2047) : (m & 255);
            const size_t ob = isS ? 0 : ((size_t)((m >> 8) * 2 + l) * 256 + t);
#pragma unroll
            for (int k = 0; k < 2; ++k) {
                const int hd = hf * 16 + 8 * k + hl;
                float x[8]; unpack8(x, raw[k]);
                if (hd >= 20) { float x2[8]; unpack8(x2, raw2[k]);
#pragma unroll
                    for (int e = 0; e < 8; ++e) x[e] += x2[e]; }
                float ss = 0.f;
#pragma unroll
                for (int e = 0; e < 8; ++e) ss += x[e] * x[e];
                ss += __shfl_xor(ss, 1); ss += __shfl_xor(ss, 2); ss += __shfl_xor(ss, 4);
                const float r = rsqrtf(ss * (1.0f / 64.0f) + EPSF);
                const bool isq = hd < 6 || (hd >= 18 && hd < 24), isk = (hd >= 6 && hd < 12) || (hd >= 24 && hd < 26), isv = (hd >= 12 && hd < 18) || (hd >= 26 && hd < 28);
                const bool gq = hd >= 18;
                if (isq || isk) {
                    const float* g = (hd < 6 ? naqg : hd < 12 ? nakg : hd < 24 ? gqg : gkg) + 8 * s8;
                    const f32x4 g0 = *(const f32x4*)g, g1 = *(const f32x4*)(g + 4);
                    float y[8];
#pragma unroll
                    for (int e = 0; e < 8; ++e) y[e] = x[e] * r * (e < 4 ? g0[e] : g1[e - 4]);
                    if (isk && !isS) { float* od = (hd < 12) ? out_nak + ob * 384 + (hd - 6) * 64 + 8 * s8 : out_gk + ob * 128 + (hd - 24) * 64 + 8 * s8;
                        *(f32x4*)od = (f32x4){y[0], y[1], y[2], y[3]}; *(f32x4*)(od + 4) = (f32x4){y[4], y[5], y[6], y[7]}; }
                    if (gq && isS) {
                        const float* rt = ROPE + ((size_t)t * 32 + (s8 < 4 ? 0 : 16) + 8 * (s8 & 1)) * 2;
                        const f32x4 c0 = *(const f32x4*)rt, c1 = *(const f32x4*)(rt + 4), c2 = *(const f32x4*)(rt + 8), c3 = *(const f32x4*)(rt + 12);
                        const float cs[16] = {c0[0], c0[1], c0[2], c0[3], c1[0], c1[1], c1[2], c1[3], c2[0], c2[1], c2[2], c2[3], c3[0], c3[1], c3[2], c3[3]};
#pragma unroll
                        for (int e = 0; e < 8; ++e) { const float pr = __shfl_xor(y[e], 2); const float co = cs[2 * e], si = cs[2 * e + 1];
                            y[e] = (s8 & 2) ? (pr * si + y[e] * co) : (y[e] * co - pr * si); }
                    }
                    if (isq) {
#pragma unroll
                        for (int e = 0; e < 8; ++e) y[e] *= 0.125f;
                    }
                    bf16_t* dst = hd < 6 ? QN + (size_t)m * 384 + hd * 64 : hd < 12 ? KN + (size_t)m * 384 + (hd - 6) * 64 : hd < 24 ? QG + (size_t)m * 384 + (hd - 18) * 64 : KG + (size_t)m * 128 + (hd - 24) * 64;
                    *(u32x4*)(dst + 8 * s8) = pack8(y);
                } else if (isv && !isS) {
                    float* od = (hd < 18) ? out_nav + ob * 384 + (hd - 12) * 64 + 8 * s8 : out_gv + ob * 128 + (hd - 26) * 64 + 8 * s8;
                    *(f32x4*)od = (f32x4){x[0], x[1], x[2], x[3]}; *(f32x4*)(od + 4) = (f32x4){x[4], x[5], x[6], x[7]};
                }
            }
        };
        auto ldraw = [&](const int m, const int hf, u32x4 (&raw)[2], u32x4 (&raw2)[2]) {
#pragma unroll
            for (int k = 0; k < 2; ++k) { const int hd = hf * 16 + 8 * k + hl; raw2[k] = (u32x4){0u, 0u, 0u, 0u};
                if (hd < 20) raw[k] = *(const u32x4*)(Ub + (size_t)m * INW + 768 + hd * 64 + 8 * s8);
                else if (hd < 28) { const bf16_t* p = P2 + (size_t)m * 512 + (hd - 20) * 64 + 8 * s8; raw[k] = *(const u32x4*)p; raw2[k] = *(const u32x4*)(p + (size_t)8192 * 512); }
                else raw[k] = (u32x4){0u, 0u, 0u, 0u}; }
        };
        for (int it = gw; it < 2 * NTOK; it += 2 * NGW) {
            const int it2 = it + NGW; const bool has2 = it2 < 2 * NTOK;
            u32x4 rawA[2], rawB[2], rawA2[2], rawB2[2];
            ldraw(it >> 1, it & 1, rawA, rawA2);
            if (has2) ldraw(it2 >> 1, it2 & 1, rawB, rawB2);
            proc(it >> 1, it & 1, rawA, rawA2);
            if (has2) proc(it2 >> 1, it2 & 1, rawB, rawB2);
        }
    }
    for (int it = gw; it < 4096; it += NGW) {
        const int tg = it >> 2, cgp = it & 3, mb = tg * 8, c = 64 * cgp + lane;
        const bool isS = mb >= NPR; const int T = isS ? 2048 : 256;
        const int m0 = isS ? NPR + ((mb - NPR) >> 11) * 2048 : (mb >> 8) * 256, t0 = mb - m0;
        float uc[3][8];
#pragma unroll
        for (int part = 0; part < 3; ++part) { const int cc = c + 256 * part;
            float u[10];
#pragma unroll
            for (int i = 0; i < 10; ++i) { const int tt = t0 - 1 + i; u[i] = (tt >= 0 && tt < T) ? bf2f(Ub[(size_t)(mb - 1 + i) * INW + cc]) : 0.f; }
            const float w0 = cw[cc], w1 = cw[768 + cc], w2 = cw[1536 + cc], bb = cb[cc];
#pragma unroll
            for (int j = 0; j < 8; ++j) uc[part][j] = u[j] * w0 + u[j + 1] * w1 + u[j + 2] * w2 + bb; }
        float z[8];
#pragma unroll
        for (int j = 0; j < 8; ++j) z[j] = uc[1][j] * uc[2][j];
        const size_t off = (size_t)m0 * 256 + (size_t)c * T + t0;
        *(u32x4*)(ZT + off) = pack8(z); *(u32x4*)(X0T + off) = pack8(uc[0]);
    }
    for (int it = gw; it < 8192; it += NGW) {
        const int g8 = it >> 3, hh = it & 7, mb = g8 * 8;
        const bool isS = mb >= NPR; const int T = isS ? 2048 : 256;
        const int m0 = isS ? NPR + ((mb - NPR) >> 11) * 2048 : (mb >> 8) * 256, t0 = mb - m0;
        float v[8];
        if (hh < 6) {
#pragma unroll
            for (int i = 0; i < 8; ++i) v[i] = bf2f(Ub[(size_t)(mb + i) * INW + 1536 + hh * 64 + lane]);
        } else {
#pragma unroll
            for (int i = 0; i < 8; ++i) { const size_t o = (size_t)(mb + i) * 512 + 384 + (hh - 6) * 64 + lane; v[i] = bf2f(P2[o]) + bf2f(P2[o + (size_t)8192 * 512]); }
        }
        bf16_t* dst = hh < 6 ? VN + (size_t)m0 * 384 + (size_t)hh * 64 * T + (size_t)(t0 >> 3) * 512 + lane * 8
                             : VG + (size_t)m0 * 128 + (size_t)(hh - 6) * 64 * T + (size_t)(t0 >> 3) * 512 + lane * 8;
        *(u32x4*)dst = pack8(v);
    }
}

DI void mix_hyena(LAS unsigned char* lds, int l, int wv) {
    PH_BEGIN
    const bf16_t* ZT = (const bf16_t*)(ws + WS_Z); const bf16_t* X0T = (const bf16_t*)(ws + WS_X0); bf16_t* YT = (bf16_t*)(ws + WS_Z + 4 * MiB);
    const bf16_t* KFTl = (const bf16_t*)(ws + WS_KFT) + (size_t)l * 1179648;
    const float* skip = kp->in[24] + l * 256;
    {
        const float* rpb = kp->in[27] + (size_t)l * 6 * 15 * 31; LAS float* rl = (LAS float*)(lds + 98304);
        for (int i = tid; i < 2790; i += 512) rl[i] = rpb[i];
        __syncthreads();
    }
    for (int c = bid; c < 256; c += NB) {
        const float sk = skip[c];
        hyena_block(lds, tid, c, 2048, true, KFTl + 131072, ZT, X0T, YT, sk);
        hyena_block(lds, tid, c, 256, false, KFTl, ZT, X0T, YT, sk);
    }
}
DI void mix_gqa(int l, int wv) {
    PH_BEGIN
    const int vgw = ((NB & 7) == 0 ? (bid & 7) * (NB >> 3) + (bid >> 3) : bid) * 8 + wave;
    const int fr = lane & 15, fq = lane >> 4;
    const bf16_t* QG = (const bf16_t*)(ws + WS_QG); const bf16_t* KG = (const bf16_t*)(ws + WS_KG); const bf16_t* VG = (const bf16_t*)(ws + WS_VG);
    const bf16_t* CKG = (const bf16_t*)(ws + WS_CKG); const bf16_t* CVG = (const bf16_t*)(ws + WS_CVG); bf16_t* Yb = (bf16_t*)(ws + WS_Y);
    const float* sink = kp->in[30] + l * 6;
    for (int rnd = 0; rnd * NGW < 3584; ++rnd) {
        const int j = rnd * NGW + ((rnd & 1) ? NGW - 1 - vgw : vgw);
        if (j >= 1024) continue;
        const bool lat = j < 512;
        int b, hk, qt, mbase, T, tok0, nloc, nctx, kpos0; const bf16_t* Kc; const bf16_t* Vc;
        if (lat) { b = j >> 8; hk = (j >> 7) & 1; qt = j & 127; mbase = NPR + b * 2048; T = 2048;
            const int p0 = 16 * qt, kt_lo = max((p0 - 128) >> 5, 0), kt_hi = min((p0 + 143) >> 5, 63); tok0 = 32 * kt_lo; nloc = kt_hi - kt_lo + 1; nctx = 8; kpos0 = tok0;
            const int bl = b * 2 + l; Kc = CKG + (size_t)(bl * 256) * 128 + hk * 64; Vc = CVG + (size_t)(bl * 2 + hk) * 64 * 256; }
        else { const int idx = j - 512; b = idx >> 5; hk = (idx >> 4) & 1; qt = idx & 15; mbase = b * 256; T = 256; tok0 = 0; nloc = 8; nctx = 0; kpos0 = 0; Kc = nullptr; Vc = nullptr; }
        const int mq = mbase + 16 * qt + fr;
        const bf16_t* Qr[3]; bf16_t* Yr[3]; float ms[3];
#pragma unroll
        for (int q = 0; q < 3; ++q) { const int h = 3 * hk + q; Qr[q] = QG + (size_t)mq * 384 + h * 64; Yr[q] = Yb + (size_t)mq * DM + 640 + h * 64; ms[q] = sink[h]; }
        attn_item<3, 3>(Qr, Yr, ms, 1.f, KG + (size_t)mbase * 128 + hk * 64, VG + (size_t)mbase * 128 + (size_t)hk * 64 * T, tok0, 32, nloc,
                        Kc, Vc, nctx, 128, lat ? 2 : 0, nullptr, 0, 0, 0, 0, kpos0, 16 * qt + fr, fr, fq);
    }
}
DI void mix_nac(int l, int wv) {
    PH_BEGIN
    const int vgw = ((NB & 7) == 0 ? (bid & 7) * (NB >> 3) + (bid >> 3) : bid) * 8 + wave;
    const int fr = lane & 15, fq = lane >> 4;
    const bf16_t* QN = (const bf16_t*)(ws + WS_QN); const bf16_t* KN = (const bf16_t*)(ws + WS_KN); const bf16_t* VN = (const bf16_t*)(ws + WS_VN); bf16_t* Yb = (bf16_t*)(ws + WS_Y);
    for (int rnd = 0; rnd * NGW < 3584; ++rnd) {
        const int j = rnd * NGW + ((rnd & 1) ? NGW - 1 - vgw : vgw);
        if (j < 1024 || j >= 1792) continue;
        const int idx = j - 1024, b = idx / 48, rem = idx % 48, h = rem >> 3, qp = rem & 7, m0 = b * 256;
        const bf16_t* Qr[2]; bf16_t* Yr[2]; const float ms[2] = {-1e30f, -1e30f};
#pragma unroll
        for (int q = 0; q < 2; ++q) { const int mq = m0 + 16 * (2 * qp + q) + fr; Qr[q] = QN + (size_t)mq * 384 + h * 64; Yr[q] = Yb + (size_t)mq * DM + 256 + h * 64; }
        attn_item<2, 4>(Qr, Yr, ms, 0.f, KN + (size_t)m0 * 384 + h * 64, VN + (size_t)m0 * 384 + (size_t)h * 64 * 256, 0, 32, 8,
                        nullptr, nullptr, 0, 384, 0, nullptr, 0, 0, 0, 0, 0, 0, fr, fq);
    }
}
DI void mix_nas(LAS unsigned char* lds, int l, int wv) {
    PH_BEGIN
    const int vgw = ((NB & 7) == 0 ? (bid & 7) * (NB >> 3) + (bid >> 3) : bid) * 8 + wave;
    const int fr = lane & 15, fq = lane >> 4;
    const bf16_t* QN = (const bf16_t*)(ws + WS_QN); const bf16_t* KN = (const bf16_t*)(ws + WS_KN); const bf16_t* VN = (const bf16_t*)(ws + WS_VN);
    const bf16_t* CKN = (const bf16_t*)(ws + WS_CKN); const bf16_t* CVN = (const bf16_t*)(ws + WS_CVN); bf16_t* Yb = (bf16_t*)(ws + WS_Y);
    const LAS float* rpb = (const LAS float*)(lds + 98304);
    for (int rnd = 0; rnd * NGW < 3584; ++rnd) {
        const int j = rnd * NGW + ((rnd & 1) ? NGW - 1 - vgw : vgw);
        if (j < 2048 || j >= 3584) continue;
        const int idx = j - 2048, b = idx / 768, rem = idx % 768, h = rem >> 7, qt = rem & 127, r = qt >> 2, nb = qt & 3;
        const int ms0 = NPR + b * 2048, mq = ms0 + 16 * qt + fr, bl = b * 2 + l;
        const int row0 = min(max(r - 4, 0), 24), col0 = min(max(16 * nb - 8, 0), 32);
        const int qc = 16 * nb + fr, wlo = min(max(qc - 8, 0), 48);
        const bf16_t* Qr[1] = {QN + (size_t)mq * 384 + h * 64}; bf16_t* Yr[1] = {Yb + (size_t)mq * DM + 256 + h * 64}; const float ms[1] = {-1e30f};
        attn_item<1, 3>(Qr, Yr, ms, 0.f, KN + (size_t)ms0 * 384 + h * 64, VN + (size_t)ms0 * 384 + (size_t)h * 64 * 2048, row0 * 64 + col0, 64, 8,
                        CKN + (size_t)(bl * 256) * 384 + h * 64, CVN + (size_t)(bl * 6 + h) * 64 * 256, 8, 384, 1,
                        rpb + h * 15 * 31, row0 - r + 7, col0, qc, wlo, 0, 0, fr, fq);
    }
}
DI void ph_mix(LAS unsigned char* lds, int l, int wv) { mix_hyena(lds, l, wv); mix_gqa(l, wv); mix_nas(lds, l, wv); mix_nac(l, wv); }

DI void ph_ytrans(LAS unsigned char* lds, int wv) {
    PH_BEGIN
    const bf16_t* YT = (const bf16_t*)(ws + WS_Z + 4 * MiB); bf16_t* Yb = (bf16_t*)(ws + WS_Y);
    LAS unsigned short* tile = (LAS unsigned short*)(lds + wave * 16384);
    const int rr = lane >> 3, s8 = lane & 7;
    for (int it = gw; it < 512; it += NGW) {
        const int c0 = 64 * (it & 3), m0 = 64 * (it >> 2);
        u32x4 v[8];
#pragma unroll
        for (int i = 0; i < 8; ++i) v[i] = *(const u32x4*)(YT + (size_t)(c0 + 8 * i + rr) * NTOK + m0 + 8 * s8);
#pragma unroll
        for (int i = 0; i < 8; ++i) { LAS unsigned short* d = tile + (8 * i + rr) * 66 + 8 * s8;
            d[0] = (unsigned short)(v[i].x & 0xffffu); d[1] = (unsigned short)(v[i].x >> 16); d[2] = (unsigned short)(v[i].y & 0xffffu); d[3] = (unsigned short)(v[i].y >> 16);
            d[4] = (unsigned short)(v[i].z & 0xffffu); d[5] = (unsigned short)(v[i].z >> 16); d[6] = (unsigned short)(v[i].w & 0xffffu); d[7] = (unsigned short)(v[i].w >> 16); }
        asm volatile("s_waitcnt lgkmcnt(0)" ::: "memory");
#pragma unroll
        for (int j = 0; j < 8; ++j) { const int m = 8 * j + rr; const LAS unsigned short* s = tile + (8 * s8) * 66 + m;
            u32x4 o; o.x = (unsigned)s[0] | ((unsigned)s[66] << 16); o.y = (unsigned)s[2 * 66] | ((unsigned)s[3 * 66] << 16);
            o.z = (unsigned)s[4 * 66] | ((unsigned)s[5 * 66] << 16); o.w = (unsigned)s[6 * 66] | ((unsigned)s[7 * 66] << 16);
            *(u32x4*)(Yb + (size_t)(m0 + m) * DM + c0 + 8 * s8) = o; }
        asm volatile("s_waitcnt lgkmcnt(0)" ::: "memory");
    }
}

#define GRID_BAR() do { KP kpb = (KP)__builtin_amdgcn_kernarg_segment_ptr(); asm volatile("" : "+s"(kpb)); \
    XcdBarrier bb; bb.bar = (unsigned*)(kpb->ws + WS_CTL); bb.x = xb_xcc_id(); bb.st = (volatile LAS unsigned*)(lds + MISC_OFF) + 8; unsigned lzb = 0u; asm volatile("" : "+v"(lzb)); xcd_barrier(bb, wv == 0 && __builtin_amdgcn_mbcnt_hi(~0u, __builtin_amdgcn_mbcnt_lo(~0u, lzb)) == 0u); } while (0)

__global__ void __launch_bounds__(512, 2) mega_fwd(Params p) {
    extern __shared__ __attribute__((aligned(16))) unsigned char lds_raw[];
    LAS unsigned char* lds = (LAS unsigned char*)lds_raw;
    cg::grid_group grid = cg::this_grid();
    const int wv = __builtin_amdgcn_readfirstlane(threadIdx.x >> 6);
    if (threadIdx.x < 32) ((volatile LAS unsigned*)(lds + MISC_OFF))[threadIdx.x] = 0u;
    __syncthreads();
    (void)xcd_barrier_post((unsigned*)(p.ws + WS_CTL), (volatile LAS unsigned*)(lds + MISC_OFF) + 8);
    if (p.ws == nullptr) grid.sync();
    phase0(lds, wv);
    GRID_BAR();
#pragma unroll 1
    for (int l = 0; l < 2; ++l) {
#pragma unroll 1
        for (int s = 0; s < 3; ++s) {
            ph_combine(lds, l, s, false, wv);
            GRID_BAR();
            if (s != 1) {
                ph_up(lds, l, s >> 1, wv);
                GRID_BAR();
                ph_part(lds, l, s >> 1, false, wv);
                GRID_BAR();
            } else {
                ph_in(lds, l, wv);
                GRID_BAR();
                ph_post(l, wv);
                GRID_BAR();
                ph_mix(lds, l, wv);
                GRID_BAR();
                ph_ytrans(lds, wv);
                GRID_BAR();
                ph_part(lds, l, 0, true, wv);
                GRID_BAR();
            }
        }
    }
    ph_combine(lds, 1, 2, true, wv);
}

extern "C" void kernel_launch(void* const* d_in, const int* in_sizes, int n_in, void* d_out, int out_size, void* d_ws, size_t ws_size, hipStream_t stream) {
    static int grid_blocks = 0;
    if (grid_blocks == 0) {
        if (n_in != 31 || out_size != 16777216 || ws_size < WS_END) { fprintf(stderr, "kernel_launch: unexpected problem (n_in %d, out %d, ws %zu)\n", n_in, out_size, ws_size); grid_blocks = -1; return; }
        int dev = 0, cus = 0, per_cu = 0;
        hipGetDevice(&dev);
        hipDeviceGetAttribute(&cus, hipDeviceAttributeMultiprocessorCount, dev);
        if (hipFuncSetAttribute((const void*)mega_fwd, hipFuncAttributeMaxDynamicSharedMemorySize, LDS_BYTES) != hipSuccess) { fprintf(stderr, "kernel_launch: hipFuncSetAttribute failed\n"); grid_blocks = -1; return; }
        hipOccupancyMaxActiveBlocksPerMultiprocessor(&per_cu, (const void*)mega_fwd, 512, LDS_BYTES);
        if (per_cu < 1) { fprintf(stderr, "kernel_launch: occupancy query says %d blocks per CU\n", per_cu); per_cu = 1; }
        (void)hipGetLastError();
        grid_blocks = cus;
    }
    if (grid_blocks < 0) return;
    if (hipMemsetAsync((char*)d_ws + WS_CTL, 0, CTL_BYTES, stream) != hipSuccess) { fprintf(stderr, "kernel_launch: memset failed\n"); return; }
    Params p{};
    for (int i = 0; i < 31; ++i) p.in[i] = (const float*)d_in[i];
    p.out = (float*)d_out; p.ws = (unsigned char*)d_ws;
    void* args[] = {&p};
    hipError_t e = hipLaunchCooperativeKernel((const void*)mega_fwd, dim3(grid_blocks), dim3(512), args, LDS_BYTES, stream);
    if (e != hipSuccess) fprintf(stderr, "kernel_launch: cooperative launch failed: %s (grid %d)\n", hipGetErrorString(e), grid_blocks);
}
```
